# Optimizing an MI355X kernel written in HIP

```python
import math
import jax
import jax.numpy as jnp
from jax import lax
import numpy as np

D_MODEL = 1024
BATCH = 8
SEQ = 2048
DEPTH = 2

GRID_W = 64
CTX_LEN = 256
HEAD_DIM = 64
N_GROUPS = 4
GROUP_HEADS = D_MODEL // (N_GROUPS * HEAD_DIM)
GROUP_WIDTH = GROUP_HEADS * HEAD_DIM
MIX_WIDTH = N_GROUPS * GROUP_WIDTH
A_KV_HEADS = GROUP_HEADS // 2
B_KV_HEADS = GROUP_HEADS // 2
D_SUB = HEAD_DIM // 2
WINDOW = 128
BLOCK = 128
NA_KR = 8
NA_KC = 16
D_FF = 2816
ROPE_BASE = 10000.0
NORM_EPS = 1e-6
N_MOD = 9
NEG_INF = -1e30
IN_SPLITS = (GROUP_WIDTH, A_KV_HEADS * HEAD_DIM, A_KV_HEADS * HEAD_DIM,
             GROUP_WIDTH, B_KV_HEADS * HEAD_DIM, B_KV_HEADS * HEAD_DIM,
             GROUP_WIDTH, GROUP_WIDTH, GROUP_WIDTH,
             GROUP_WIDTH, GROUP_WIDTH, GROUP_WIDTH)
IN_WIDTH = int(sum(IN_SPLITS))
IN_SPLIT_OFFSETS = tuple(int(o) for o in np.cumsum(IN_SPLITS)[:-1])

kernel_name = 'hybrid_parallel_heads_diffusion_block'


def rms_norm(x, g=None):
    xf = x.astype(jnp.float32)
    y = xf * lax.rsqrt(jnp.mean(xf * xf, axis=-1, keepdims=True) + NORM_EPS)
    if g is not None:
        y = y * g.astype(jnp.float32)
    return y.astype(x.dtype)


def modulate(x, shift, scale):
    return rms_norm(x) * (1.0 + scale) + shift


def swiglu(h, w_gate, w_up, w_down):
    return (jax.nn.silu(h @ w_gate) * (h @ w_up)) @ w_down


def axial_rope(n_tokens, dim):
    t = jnp.arange(n_tokens, dtype=jnp.int32)
    row = (t // GRID_W).astype(jnp.float32)
    col = (t % GRID_W).astype(jnp.float32)
    half = dim // 2
    freqs = ROPE_BASE ** (-jnp.arange(0, half, 2, dtype=jnp.float32) / half)
    ang_r = row[:, None] * freqs[None, :]
    ang_c = col[:, None] * freqs[None, :]
    ang = jnp.concatenate([ang_r, ang_r, ang_c, ang_c], axis=-1)
    return jnp.cos(ang), jnp.sin(ang)


def apply_rope(x, cos, sin):
    d = x.shape[-1]
    h = d // 2
    qd = h // 2

    def rot(u):
        return jnp.concatenate([-u[..., qd:], u[..., :qd]], axis=-1)

    rotated = jnp.concatenate([rot(x[..., :h]), rot(x[..., h:])], axis=-1)
    shape = (x.shape[1],) + (1,) * (x.ndim - 3) + (d,)
    out = x.astype(jnp.float32) * cos.reshape(shape) + rotated.astype(jnp.float32) * sin.reshape(shape)
    return out.astype(x.dtype)


def window_attention(q, k, v, k_ctx, v_ctx, sink):
    B, S, H, dh = q.shape
    hkv = k.shape[2]
    G = H // hkv
    L = k_ctx.shape[1]
    nb = S // BLOCK
    span = BLOCK + 2 * WINDOW
    pad = ((0, 0), (WINDOW, WINDOW), (0, 0), (0, 0))
    idx = jnp.arange(nb)[:, None] * BLOCK + jnp.arange(span)[None, :]
    kb = jnp.pad(k, pad)[:, idx]
    vb = jnp.pad(v, pad)[:, idx]
    qb = q.reshape(B, nb, BLOCK, hkv, G, dh)
    scale = dh ** -0.5
    s_loc = jnp.einsum('bnqhgd,bnjhd->bnhgqj', qb, kb, preferred_element_type=jnp.float32) * scale
    q_pos = jnp.arange(nb)[:, None] * BLOCK + jnp.arange(BLOCK)[None, :]
    k_pos = idx - WINDOW
    valid = ((jnp.abs(k_pos[:, None, :] - q_pos[:, :, None]) <= WINDOW)
             & (k_pos[:, None, :] >= 0) & (k_pos[:, None, :] < S))
    s_loc = jnp.where(valid[None, :, None, None], s_loc, NEG_INF)
    s_ctx = jnp.einsum('bnqhgd,bjhd->bnhgqj', qb, k_ctx, preferred_element_type=jnp.float32) * scale
    s_sink = jnp.broadcast_to(sink.astype(jnp.float32).reshape(1, 1, hkv, G, 1, 1), s_loc.shape[:-1] + (1,))
    p = jax.nn.softmax(jnp.concatenate([s_loc, s_ctx, s_sink], axis=-1), axis=-1).astype(v.dtype)
    out = (jnp.einsum('bnhgqj,bnjhd->bnqhgd', p[..., :span], vb)
           + jnp.einsum('bnhgqj,bjhd->bnqhgd', p[..., span:span + L], v_ctx))
    return out.reshape(B, S, H, dh)


def context_sink_attention(q, k, v, sink):
    B, L, H, dh = q.shape
    hkv = k.shape[2]
    G = H // hkv
    qg = q.reshape(B, L, hkv, G, dh)
    s = jnp.einsum('bqhgd,bjhd->bhgqj', qg, k, preferred_element_type=jnp.float32) * (dh ** -0.5)
    s_sink = jnp.broadcast_to(sink.astype(jnp.float32).reshape(1, hkv, G, 1, 1), s.shape[:-1] + (1,))
    p = jax.nn.softmax(jnp.concatenate([s, s_sink], axis=-1), axis=-1).astype(v.dtype)
    out = jnp.einsum('bhgqj,bjhd->bqhgd', p[..., :L], v)
    return out.reshape(B, L, H, dh)


def blocked_gqa(q, k, v):
    B, T, H, dh = q.shape
    hkv = k.shape[2]
    G = H // hkv
    nb = T // BLOCK
    scale = dh ** -0.5
    qb = jnp.moveaxis(q.reshape(B, nb, BLOCK, hkv, G, dh), 1, 0)

    def one_block(qblk):
        s = jnp.einsum('bqhgd,bjhd->bhgqj', qblk, k, preferred_element_type=jnp.float32) * scale
        p = jax.nn.softmax(s, axis=-1).astype(v.dtype)
        return jnp.einsum('bhgqj,bjhd->bqhgd', p, v)

    out = lax.map(one_block, qb)
    return jnp.moveaxis(out, 0, 1).reshape(B, T, H, dh)


def neighbourhood_attention(q, k, v, k_ctx, v_ctx, rel_bias, rows):
    B, S, H, dh = q.shape
    kr = min(NA_KR, rows)
    r = jnp.arange(rows)
    r_start = jnp.clip(r - kr // 2, 0, rows - kr)
    key_rows = r_start[:, None] + jnp.arange(kr)[None, :]
    kg = k.reshape(B, rows, GRID_W, H, dh)[:, key_rows].reshape(B, rows, kr * GRID_W, H, dh)
    vg = v.reshape(B, rows, GRID_W, H, dh)[:, key_rows].reshape(B, rows, kr * GRID_W, H, dh)
    qg = q.reshape(B, rows, GRID_W, H, dh)
    scale = dh ** -0.5
    s_loc = jnp.einsum('brqhd,brjhd->brhqj', qg, kg, preferred_element_type=jnp.float32) * scale
    col = jnp.arange(GRID_W)
    c_start = jnp.clip(col - NA_KC // 2, 0, GRID_W - NA_KC)
    col_ok = (col[None, :] >= c_start[:, None]) & (col[None, :] < c_start[:, None] + NA_KC)
    dr_idx = key_rows - r[:, None] + NA_KR - 1
    dc_idx = jnp.clip(col[None, :] - col[:, None] + NA_KC - 1, 0, 2 * NA_KC - 2)
    bias = rel_bias[:, dr_idx[:, None, :, None], dc_idx[None, :, None, :]]
    bias = bias.reshape(H, rows, GRID_W, kr * GRID_W).transpose(1, 0, 2, 3)
    mask = jnp.broadcast_to(col_ok[:, None, :], (GRID_W, kr, GRID_W)).reshape(GRID_W, kr * GRID_W)
    s_loc = jnp.where(mask, s_loc + bias.astype(jnp.float32), NEG_INF)
    s_ctx = jnp.einsum('brqhd,bjhd->brhqj', qg, k_ctx, preferred_element_type=jnp.float32) * scale
    n_loc = kr * GRID_W
    p = jax.nn.softmax(jnp.concatenate([s_loc, s_ctx], axis=-1), axis=-1).astype(v.dtype)
    out = (jnp.einsum('brhqj,brjhd->brqhd', p[..., :n_loc], vg)
           + jnp.einsum('brhqj,bjhd->brqhd', p[..., n_loc:], v_ctx))
    return out.reshape(B, S, H, dh)


def blocked_diff_attention(q, k, v, lam):
    B, T, H = q.shape[:3]
    nb = T // BLOCK
    scale = D_SUB ** -0.5
    qb = jnp.moveaxis(q.reshape(B, nb, BLOCK, H, 2, D_SUB), 1, 0)

    def one_block(qblk):
        s = jnp.einsum('bqhtd,bjhtd->bhtqj', qblk, k, preferred_element_type=jnp.float32) * scale
        p = jax.nn.softmax(s, axis=-1)
        a = (p[:, :, 0] - lam * p[:, :, 1]).astype(v.dtype)
        return jnp.einsum('bhqj,bjhe->bqhe', a, v)

    out = lax.map(one_block, qb)
    return jnp.moveaxis(out, 0, 1).reshape(B, T, H, v.shape[-1])


def hybrid_mixer(h, hc, rows, w_in, w_out, sink, q_norm_g, k_norm_g, rel_bias, lam, lam_init, subln_g,
                 with_ctx_out):
    B, S, _ = h.shape
    L = hc.shape[1]
    cos_h, sin_h = axial_rope(S, HEAD_DIM)
    cos_s, sin_s = axial_rope(S, D_SUB)
    aq, ak, av, bq, bk, bv, cq, ck, cv, dq, dk, dv = jnp.split(h @ w_in, IN_SPLIT_OFFSETS, axis=-1)
    aqc, akc, avc, bqc, bkc, bvc, cqc, ckc, cvc, dqc, dkc, dvc = jnp.split(hc @ w_in, IN_SPLIT_OFFSETS, axis=-1)

    def heads(t, n):
        return t.reshape(t.shape[0], t.shape[1], n, HEAD_DIM)

    def sub_heads(t):
        return t.reshape(t.shape[0], t.shape[1], GROUP_HEADS, 2, D_SUB)

    ka_c, va_c = heads(akc, A_KV_HEADS), heads(avc, A_KV_HEADS)
    y_a = window_attention(apply_rope(heads(aq, GROUP_HEADS), cos_h, sin_h),
                           apply_rope(heads(ak, A_KV_HEADS), cos_h, sin_h),
                           heads(av, A_KV_HEADS), ka_c, va_c, sink)
    kb_c = rms_norm(heads(bkc, B_KV_HEADS), k_norm_g)
    vb_c = heads(bvc, B_KV_HEADS)
    qb = apply_rope(rms_norm(heads(bq, GROUP_HEADS), q_norm_g), cos_h, sin_h)
    kb = apply_rope(rms_norm(heads(bk, B_KV_HEADS), k_norm_g), cos_h, sin_h)
    y_b = blocked_gqa(qb, jnp.concatenate([kb, kb_c], axis=1),
                      jnp.concatenate([heads(bv, B_KV_HEADS), vb_c], axis=1))
    kc_c, vc_c = heads(ckc, GROUP_HEADS), heads(cvc, GROUP_HEADS)
    y_c = neighbourhood_attention(heads(cq, GROUP_HEADS), heads(ck, GROUP_HEADS), heads(cv, GROUP_HEADS),
                                  kc_c, vc_c, rel_bias, rows)
    kd_c, vd_c = sub_heads(dkc), heads(dvc, GROUP_HEADS)
    qd = apply_rope(sub_heads(dq), cos_s, sin_s)
    kd = apply_rope(sub_heads(dk), cos_s, sin_s)
    y_d = blocked_diff_attention(qd, jnp.concatenate([kd, kd_c], axis=1),
                                 jnp.concatenate([heads(dv, GROUP_HEADS), vd_c], axis=1), lam)
    y_d = rms_norm(y_d, subln_g) * (1.0 - lam_init)
    y = jnp.concatenate([t.reshape(B, S, GROUP_WIDTH) for t in (y_a, y_b, y_c, y_d)], axis=-1) @ w_out
    if not with_ctx_out:
        return y, None
    yc_a = context_sink_attention(heads(aqc, GROUP_HEADS), ka_c, va_c, sink)
    yc_b = blocked_gqa(rms_norm(heads(bqc, GROUP_HEADS), q_norm_g), kb_c, vb_c)
    yc_c = blocked_gqa(heads(cqc, GROUP_HEADS), kc_c, vc_c)
    yc_d = rms_norm(blocked_diff_attention(sub_heads(dqc), kd_c, vd_c, lam), subln_g) * (1.0 - lam_init)
    yc = jnp.concatenate([t.reshape(B, L, GROUP_WIDTH) for t in (yc_a, yc_b, yc_c, yc_d)], axis=-1) @ w_out
    return y, yc


def setup_inputs(seed: int = 0) -> dict:
    key = jax.random.key(seed)
    ks = jax.random.split(key, 24)
    f32 = jnp.float32
    nrm = jax.random.normal

    def dense(k, shape, fan_in, gain=1.0):
        return nrm(k, shape, f32) * (gain * fan_in ** -0.5)

    return {
        'x': nrm(ks[0], (BATCH, SEQ, D_MODEL), f32),
        'c': nrm(ks[1], (BATCH, D_MODEL), f32),
        'ctx': nrm(ks[2], (BATCH, CTX_LEN, D_MODEL), f32),
        'c_ctx': nrm(ks[3], (D_MODEL,), f32),
        'w_ada': dense(ks[4], (DEPTH, D_MODEL, N_MOD * D_MODEL), D_MODEL, 0.5),
        'b_ada': 0.02 * nrm(ks[5], (DEPTH, N_MOD * D_MODEL), f32),
        'w_ffn1_gate': dense(ks[6], (DEPTH, D_MODEL, D_FF), D_MODEL),
        'w_ffn1_up': dense(ks[7], (DEPTH, D_MODEL, D_FF), D_MODEL),
        'w_ffn1_down': dense(ks[8], (DEPTH, D_FF, D_MODEL), D_FF),
        'w_in': dense(ks[9], (DEPTH, D_MODEL, IN_WIDTH), D_MODEL),
        'w_out': dense(ks[10], (DEPTH, MIX_WIDTH, D_MODEL), MIX_WIDTH),
        'sink_logit': 0.5 * nrm(ks[11], (DEPTH, GROUP_HEADS), f32),
        'q_norm_g': 1.0 + 0.1 * nrm(ks[12], (DEPTH, HEAD_DIM), f32),
        'k_norm_g': 1.0 + 0.1 * nrm(ks[13], (DEPTH, HEAD_DIM), f32),
        'rel_pos_bias': 0.1 * nrm(ks[14], (DEPTH, GROUP_HEADS, 2 * NA_KR - 1, 2 * NA_KC - 1), f32),
        'lam_q1': 0.1 * nrm(ks[15], (DEPTH, D_SUB), f32),
        'lam_k1': 0.1 * nrm(ks[16], (DEPTH, D_SUB), f32),
        'lam_q2': 0.1 * nrm(ks[17], (DEPTH, D_SUB), f32),
        'lam_k2': 0.1 * nrm(ks[18], (DEPTH, D_SUB), f32),
        'subln_g': 1.0 + 0.1 * nrm(ks[19], (DEPTH, HEAD_DIM), f32),
        'w_ffn2_gate': dense(ks[20], (DEPTH, D_MODEL, D_FF), D_MODEL),
        'w_ffn2_up': dense(ks[21], (DEPTH, D_MODEL, D_FF), D_MODEL),
        'w_ffn2_down': dense(ks[22], (DEPTH, D_FF, D_MODEL), D_FF),
        'final_norm_g': 1.0 + 0.1 * nrm(ks[23], (D_MODEL,), f32),
    }


def reference(x, c, ctx, c_ctx, w_ada, b_ada, w_ffn1_gate, w_ffn1_up, w_ffn1_down, w_in, w_out,
              sink_logit, q_norm_g, k_norm_g, rel_pos_bias, lam_q1, lam_k1, lam_q2, lam_k2, subln_g,
              w_ffn2_gate, w_ffn2_up, w_ffn2_down, final_norm_g):
    B = x.shape[0]
    rows = x.shape[1] // GRID_W
    xc = ctx
    silu_c = jax.nn.silu(c)
    silu_cc = jax.nn.silu(c_ctx)
    for l in range(DEPTH):
        last = l == DEPTH - 1
        mod = (silu_c @ w_ada[l] + b_ada[l]).reshape(B, N_MOD, 1, D_MODEL)
        mod_c = (silu_cc @ w_ada[l] + b_ada[l]).reshape(N_MOD, 1, 1, D_MODEL)
        x = x + 0.5 * mod[:, 2] * swiglu(modulate(x, mod[:, 0], mod[:, 1]),
                                         w_ffn1_gate[l], w_ffn1_up[l], w_ffn1_down[l])
        xc = xc + 0.5 * mod_c[2] * swiglu(modulate(xc, mod_c[0], mod_c[1]),
                                          w_ffn1_gate[l], w_ffn1_up[l], w_ffn1_down[l])
        lam_init = 0.8 - 0.6 * math.exp(-0.3 * l)
        lam = (jnp.exp(jnp.sum(lam_q1[l].astype(jnp.float32) * lam_k1[l].astype(jnp.float32)))
               - jnp.exp(jnp.sum(lam_q2[l].astype(jnp.float32) * lam_k2[l].astype(jnp.float32)))
               + lam_init)
        h = modulate(x, mod[:, 3], mod[:, 4])
        hc = modulate(xc, mod_c[3], mod_c[4])
        y, yc = hybrid_mixer(h, hc, rows, w_in[l], w_out[l], sink_logit[l], q_norm_g[l], k_norm_g[l],
                             rel_pos_bias[l], lam, lam_init, subln_g[l], not last)
        x = x + mod[:, 5] * y
        if not last:
            xc = xc + mod_c[5] * yc
            xc = xc + 0.5 * mod_c[8] * swiglu(modulate(xc, mod_c[6], mod_c[7]),
                                              w_ffn2_gate[l], w_ffn2_up[l], w_ffn2_down[l])
        x = x + 0.5 * mod[:, 8] * swiglu(modulate(x, mod[:, 6], mod[:, 7]),
                                         w_ffn2_gate[l], w_ffn2_up[l], w_ffn2_down[l])
    return rms_norm(x, final_norm_g)
```

```cpp
#include <hip/hip_runtime.h>
#include <hip/hip_cooperative_groups.h>
#include <cstdio>
#include <cstdint>
namespace cg = cooperative_groups;
__device__ __forceinline__ int tid_now() { int t = (int)threadIdx.x; asm volatile("" : "+v"(t)); return t; }
__device__ __forceinline__ int bid_now() { int t = (int)blockIdx.x; asm volatile("" : "+s"(t)); return t; }
__device__ __forceinline__ int grd_now() { int t = (int)gridDim.x; asm volatile("" : "+s"(t)); return t; }
namespace pg8 {
#define PG8_LAS __attribute__((address_space(3)))
typedef unsigned short bf16_t;
typedef short bf16x8 __attribute__((ext_vector_type(8)));
typedef float f32x4 __attribute__((ext_vector_type(4)));
typedef unsigned u32x4 __attribute__((ext_vector_type(4)));
constexpr int BM = 256, BK = 64, HALF = 128, HTB = HALF * BK * 2  , STAGE_BYTES = 8 * HTB, NXCD = 8, WGM = 8;

__host__ __device__ __forceinline__ int lds_byte(int r, int c) { const int st = (r >> 4) * 2 + (c >> 5), rr = r & 15, cc = c & 31, ob = rr * 64 + cc * 2; return st * 1024 + (ob ^ (((ob >> 9) & 1) << 5)); }
__host__ __device__ __forceinline__ void stage_rc(int b, int& R, int& C) { const int st = b / 1024, sb = b % 1024, swz = sb ^ (((sb >> 9) & 1) << 5); R = (st >> 1) * 16 + swz / 64; C = (st & 1) * 32 + (swz % 64) / 2; }
__host__ __device__ __forceinline__ int perm32(int rho) { const int n = rho >> 4, i = rho & 15; return 8 * (i >> 2) + 4 * n + (i & 3); }

struct Unit { int pm, pn, k0, nk, pt; };
struct Gemm { const bf16_t* A; const bf16_t* Bt; int M, N, K; };

struct StaticOrder {
    int nM, nN, nwg, G, c, nK;
    __host__ __device__ void init(int M, int N, int G_, int c_, int K_) { nM = M / BM; nN = N / BM; nwg = nM * nN; G = G_; c = c_; nK = K_ / BK; }
    __host__ __device__ bool next(int i, Unit& u) const {
        const long L = (long)i * G + c; if (L >= nwg) return false;
        int wgid = (int)L; { const int q = nwg / NXCD, r = nwg % NXCD, xcd = wgid % NXCD, off = wgid / NXCD; wgid = (xcd < r ? xcd * (q + 1) : r * (q + 1) + (xcd - r) * q) + off; }
        const int nig = WGM * nN, gid = wgid / nig, fm = gid * WGM, gsz = (nM - fm) < WGM ? (nM - fm) : WGM;
        u.pm = fm + ((wgid % nig) % gsz); u.pn = (wgid % nig) / gsz; u.k0 = 0; u.nk = nK; u.pt = 0; return true;
    }
    __device__ __forceinline__ void a_ready(const Unit&) const {}
    __device__ __forceinline__ void done(const Unit&) const {}
};
typedef __bf16 bf16x2c_t __attribute__((ext_vector_type(2)));
typedef float f32x2c_t __attribute__((ext_vector_type(2)));
__device__ __forceinline__ unsigned cvt_pk_bf16(float lo, float hi) { f32x2c_t v = {lo, hi}; bf16x2c_t r = __builtin_convertvector(v, bf16x2c_t); return __builtin_bit_cast(unsigned, r); }
typedef float f32x2 __attribute__((ext_vector_type(2)));
template <class Epi, class Sched, bool ALIGN_EPI = false, bool SP2 = false>
__device__ __forceinline__ void gemm_phase(PG8_LAS unsigned char* lds, const Gemm g, const Sched& S, const Epi& E) {
    const int tid = tid_now(), wid = __builtin_amdgcn_readfirstlane(tid >> 6), lane = tid & 63, wr = wid >> 2, wc = wid & 3, fr = lane & 15, fq = lane >> 4;
    const int K = g.K;
    unsigned voffA[2], voffB[2];
#pragma unroll
    for (int i = 0; i < 2; ++i) { int R, C; stage_rc(tid * 16 + i * 8192, R, C); const int Rb = Epi::PERM ? ((R & ~31) + perm32(R & 31)) : R;
        voffA[i] = (unsigned)(R * K + C) * 2u; voffB[i] = (unsigned)(Rb * K + C) * 2u; }
    const size_t kstep = (size_t)(BK * 2);
    const size_t hstep = (size_t)HALF * K * 2;
    const size_t tstep = 2 * hstep;
    const unsigned ldsw = (unsigned)wid * 1024u;
    const int aoff = lds_byte(wr * 64 + fr, fq * 8), boff = lds_byte(wc * 32 + fr, fq * 8);
#define PG8_SA(b, h) (((b) * 2 + (h)) * HTB)
#define PG8_SB(b, h) ((4 + (b) * 2 + (h)) * HTB)
#define PG8_STAGE(bufoff, gbase, voff) do { _Pragma("unroll") for (int _i = 0; _i < 2; ++_i) \
        __builtin_amdgcn_global_load_lds((const unsigned*)((const char*)(gbase) + (voff)[_i]), (PG8_LAS unsigned*)(lds + (bufoff) + ldsw + _i * 8192), 16, 0, 0); } while (0)
#define PG8_LDA(dst, b, h) do { _Pragma("unroll") for (int m = 0; m < 4; ++m) _Pragma("unroll") for (int k = 0; k < 2; ++k) dst[m][k] = *(const PG8_LAS bf16x8*)(lds + PG8_SA(b, h) + aoff + m * 2048 + k * 1024); } while (0)
#define PG8_LDB(dst, b, h) do { _Pragma("unroll") for (int n = 0; n < 2; ++n) _Pragma("unroll") for (int k = 0; k < 2; ++k) dst[n][k] = *(const PG8_LAS bf16x8*)(lds + PG8_SB(b, h) + boff + n * 2048 + k * 1024); } while (0)
#define PG8_MMA(ai, bj, At, Bt) do { __builtin_amdgcn_s_setprio(1); _Pragma("unroll") for (int m = 0; m < 4; ++m) _Pragma("unroll") for (int n = 0; n < 2; ++n) _Pragma("unroll") for (int k = 0; k < 2; ++k) \
        acc[ai][bj][m][n] = __builtin_amdgcn_mfma_f32_16x16x32_bf16(Bt[n][k], At[m][k], acc[ai][bj][m][n], 0, 0, 0); __builtin_amdgcn_s_setprio(0); } while (0)
#define PG8_WAIT_V(n) asm volatile("s_waitcnt vmcnt(" #n ")" ::: "memory")
#define PG8_WAIT_L(n) asm volatile("s_waitcnt lgkmcnt(" #n ")" ::: "memory")
#define PG8_BAR __builtin_amdgcn_s_barrier()
#define PG8_SCHED __builtin_amdgcn_sched_barrier(0)
    Unit cur, nxt; int ui = 0;
    if (!S.next(0, cur)) return;
    f32x4 acc[2][2][4][2];
#pragma unroll
    for (int a = 0; a < 2; ++a)
#pragma unroll
        for (int b = 0; b < 2; ++b)
#pragma unroll
            for (int m = 0; m < 4; ++m)
#pragma unroll
                for (int n = 0; n < 2; ++n) acc[a][b][m][n] = (f32x4){0.f, 0.f, 0.f, 0.f};
    bf16x8 At[4][2], B0[2][2], B1[2][2];
    const char* cA = (const char*)g.A + (size_t)cur.pm * tstep + (size_t)cur.k0 * kstep; const char* cB = (const char*)g.Bt + (size_t)cur.pn * tstep + (size_t)cur.k0 * kstep;
    S.a_ready(cur);
    if constexpr (SP2) {
        PG8_STAGE(PG8_SB(0, 0), cB, voffB); PG8_STAGE(PG8_SB(0, 1), cB + hstep, voffB); PG8_STAGE(PG8_SA(0, 0), cA, voffA); PG8_STAGE(PG8_SA(0, 1), cA + hstep, voffA);
        if (wr == 1) PG8_BAR;
        PG8_WAIT_V(2); PG8_BAR;
        PG8_STAGE(PG8_SB(1, 0), cB + kstep, voffB); PG8_STAGE(PG8_SA(1, 0), cA + kstep, voffA); PG8_STAGE(PG8_SB(1, 1), cB + hstep + kstep, voffB);
        PG8_WAIT_V(6); PG8_BAR;
    } else {
        PG8_STAGE(PG8_SB(0, 0), cB, voffB); PG8_STAGE(PG8_SA(0, 0), cA, voffA); PG8_STAGE(PG8_SB(0, 1), cB + hstep, voffB); PG8_STAGE(PG8_SA(0, 1), cA + hstep, voffA);
        if (wr == 1) PG8_BAR;
        PG8_WAIT_V(4); PG8_BAR;
        PG8_STAGE(PG8_SB(1, 0), cB + kstep, voffB); PG8_STAGE(PG8_SA(1, 0), cA + kstep, voffA); PG8_STAGE(PG8_SB(1, 1), cB + hstep + kstep, voffB);
        PG8_WAIT_V(6); PG8_BAR;
    }
    for (;;) {
        const bool has_next = S.next(ui + 1, nxt);
        const char* nA = has_next ? (const char*)g.A + (size_t)nxt.pm * tstep + (size_t)nxt.k0 * kstep : cA; const char* nB = has_next ? (const char*)g.Bt + (size_t)nxt.pn * tstep + (size_t)nxt.k0 * kstep : cB;
        const int nt = cur.nk;
        for (int t = 0; t < nt; t += 2) {
            const bool last = (t == nt - 2);
            const char* a1 = cA + (size_t)(t + 1) * kstep;
            const char* a2 = last ? nA : cA + (size_t)(t + 2) * kstep; const char* b2 = last ? nB : cB + (size_t)(t + 2) * kstep;
            const char* a3 = a2 + kstep; const char* b3 = b2 + kstep;
            if (last && has_next) S.a_ready(nxt);
            if constexpr (SP2) {
            PG8_LDB(B0, 0, 0); PG8_LDB(B1, 0, 1); PG8_SCHED; PG8_LDA(At, 0, 0); PG8_STAGE(PG8_SA(1, 1), a1 + hstep, voffA);
            PG8_WAIT_V(8); PG8_WAIT_L(0); PG8_BAR; PG8_MMA(0, 0, At, B0); PG8_MMA(0, 1, At, B1); PG8_BAR; PG8_SCHED;
            PG8_LDA(At, 0, 1); PG8_STAGE(PG8_SB(0, 0), b2, voffB); PG8_STAGE(PG8_SB(0, 1), b2 + hstep, voffB); PG8_STAGE(PG8_SA(0, 0), a2, voffA);
            PG8_WAIT_V(8); PG8_WAIT_L(0); PG8_BAR; PG8_MMA(1, 0, At, B0); PG8_MMA(1, 1, At, B1); PG8_BAR; PG8_SCHED;
            PG8_LDB(B0, 1, 0); PG8_LDB(B1, 1, 1); PG8_SCHED; PG8_LDA(At, 1, 0); PG8_STAGE(PG8_SA(0, 1), a2 + hstep, voffA);
            PG8_WAIT_V(8); PG8_WAIT_L(0); PG8_BAR; PG8_MMA(0, 0, At, B0); PG8_MMA(0, 1, At, B1); PG8_BAR; PG8_SCHED;
            PG8_LDA(At, 1, 1); PG8_STAGE(PG8_SB(1, 0), b3, voffB); PG8_STAGE(PG8_SB(1, 1), b3 + hstep, voffB); PG8_STAGE(PG8_SA(1, 0), a3, voffA);
            PG8_WAIT_V(8); PG8_WAIT_L(0); PG8_BAR; PG8_MMA(1, 0, At, B0); PG8_MMA(1, 1, At, B1); PG8_BAR; PG8_SCHED;
            } else {
            PG8_LDB(B0, 0, 0); PG8_SCHED; PG8_LDA(At, 0, 0); PG8_STAGE(PG8_SA(1, 1), a1 + hstep, voffA);
            PG8_WAIT_L(8); PG8_BAR; PG8_WAIT_L(0); PG8_MMA(0, 0, At, B0); PG8_BAR; PG8_SCHED;
            PG8_LDB(B1, 0, 1); PG8_STAGE(PG8_SB(0, 0), b2, voffB);
            PG8_BAR; PG8_WAIT_L(0); PG8_MMA(0, 1, At, B1); PG8_BAR;
            PG8_LDA(At, 0, 1); PG8_STAGE(PG8_SA(0, 0), a2, voffA);
            PG8_BAR; PG8_WAIT_L(0); PG8_MMA(1, 0, At, B0); PG8_BAR; PG8_SCHED;
            PG8_STAGE(PG8_SB(0, 1), b2 + hstep, voffB);
            PG8_WAIT_V(6); PG8_BAR; PG8_MMA(1, 1, At, B1); PG8_BAR;
            PG8_LDB(B0, 1, 0); PG8_SCHED; PG8_LDA(At, 1, 0); PG8_STAGE(PG8_SA(0, 1), a2 + hstep, voffA);
            PG8_WAIT_L(8); PG8_BAR; PG8_WAIT_L(0); PG8_MMA(0, 0, At, B0); PG8_BAR; PG8_SCHED;
            PG8_LDB(B1, 1, 1); PG8_STAGE(PG8_SB(1, 0), b3, voffB);
            PG8_BAR; PG8_WAIT_L(0); PG8_MMA(0, 1, At, B1); PG8_BAR;
            PG8_LDA(At, 1, 1); PG8_STAGE(PG8_SA(1, 0), a3, voffA);
            PG8_BAR; PG8_WAIT_L(0); PG8_MMA(1, 0, At, B0); PG8_BAR; PG8_SCHED;
            PG8_STAGE(PG8_SB(1, 1), b3 + hstep, voffB);
            PG8_WAIT_V(6); PG8_BAR; PG8_MMA(1, 1, At, B1); PG8_BAR;
            }
        }
        if constexpr (ALIGN_EPI) { if (wr == 0) PG8_BAR; }
        if constexpr (!Epi::AFTER_DRAIN) { E(acc, cur, wr, wc, fr, fq); S.done(cur); }
        else { if (has_next) E(acc, cur, wr, wc, fr, fq); }
        if (!has_next) break;
#pragma unroll
        for (int a = 0; a < 2; ++a)
#pragma unroll
            for (int b = 0; b < 2; ++b)
#pragma unroll
                for (int m = 0; m < 4; ++m)
#pragma unroll
                    for (int n = 0; n < 2; ++n) acc[a][b][m][n] = (f32x4){0.f, 0.f, 0.f, 0.f};
        cur = nxt; cA = nA; cB = nB; ++ui;
        if constexpr (ALIGN_EPI) { if (wr == 1) PG8_BAR; }
    }
    PG8_WAIT_V(0);
    if constexpr (!ALIGN_EPI) { if (wr == 0) PG8_BAR; }
    PG8_BAR;
    if constexpr (Epi::AFTER_DRAIN) { E.fused(acc, cur, wr, wc, fr, fq, lds, wid, lane); S.done(cur); }
#undef PG8_SA
#undef PG8_SB
#undef PG8_STAGE
#undef PG8_LDA
#undef PG8_LDB
#undef PG8_MMA
#undef PG8_WAIT_V
#undef PG8_WAIT_L
#undef PG8_BAR
#undef PG8_SCHED
}
}

namespace pg8 {
__device__ __forceinline__ float silu_f(float x) { return x * __builtin_amdgcn_rcpf(1.0f + __builtin_amdgcn_exp2f(-1.44269504f * x)); }

struct EpiPlain {
    static constexpr bool PERM = true, AFTER_DRAIN = false;
    bf16_t* O; int ldc;
    __device__ __forceinline__ void operator()(const f32x4 (&acc)[2][2][4][2], const Unit& u, int wr, int wc, int fr, int fq) const {
        const int row0 = u.pm * BM + wr * 64 + fr, col0 = u.pn * BM + wc * 32 + 8 * fq;
#pragma unroll
        for (int ai = 0; ai < 2; ++ai)
#pragma unroll
            for (int m = 0; m < 4; ++m) { bf16_t* rowp = O + (size_t)(row0 + ai * HALF + m * 16) * ldc + col0;
#pragma unroll
                for (int bj = 0; bj < 2; ++bj) { const f32x4 v0 = acc[ai][bj][m][0], v1 = acc[ai][bj][m][1]; u32x4 w;
                    w.x = cvt_pk_bf16(v0[0], v0[1]); w.y = cvt_pk_bf16(v0[2], v0[3]); w.z = cvt_pk_bf16(v1[0], v1[1]); w.w = cvt_pk_bf16(v1[2], v1[3]);
                    *(u32x4*)(rowp + bj * HALF) = w; } }
    }
};
struct EpiSwiglu {
    static constexpr bool PERM = true, AFTER_DRAIN = false;
    bf16_t* O; int ldc;
    __device__ __forceinline__ void operator()(const f32x4 (&acc)[2][2][4][2], const Unit& u, int wr, int wc, int fr, int fq) const {
        const int row0 = u.pm * BM + wr * 64 + fr, col0 = u.pn * HALF + wc * 32 + 8 * fq;
#pragma unroll
        for (int ai = 0; ai < 2; ++ai)
#pragma unroll
            for (int m = 0; m < 4; ++m) { bf16_t* rowp = O + (size_t)(row0 + ai * HALF + m * 16) * ldc + col0;
                const f32x4 g0 = acc[ai][0][m][0], g1 = acc[ai][0][m][1], u0 = acc[ai][1][m][0], u1 = acc[ai][1][m][1]; u32x4 w;
                w.x = cvt_pk_bf16(silu_f(g0[0]) * u0[0], silu_f(g0[1]) * u0[1]); w.y = cvt_pk_bf16(silu_f(g0[2]) * u0[2], silu_f(g0[3]) * u0[3]);
                w.z = cvt_pk_bf16(silu_f(g1[0]) * u1[0], silu_f(g1[1]) * u1[1]); w.w = cvt_pk_bf16(silu_f(g1[2]) * u1[2], silu_f(g1[3]) * u1[3]);
                *(u32x4*)rowp = w; }
    }
};
typedef unsigned u32x2 __attribute__((ext_vector_type(2)));
typedef __bf16 bf16x2b_t __attribute__((ext_vector_type(2)));
__device__ __forceinline__ unsigned cvt_pk_bf16_b(float lo, float hi) { f32x2 v = {lo, hi}; bf16x2b_t r = __builtin_convertvector(v, bf16x2b_t); return __builtin_bit_cast(unsigned, r); }
struct EpiRes {
    static constexpr bool PERM = false, AFTER_DRAIN = true;
    float* x_l; float* x_c; const float* gate; float gs; int nk_full; float* part;
    const float* xin_l; const float* xin_c;
    int fuse, final; bf16_t* H; const float* nsh;
    float* slots; unsigned* cnt;
    __device__ __forceinline__ void operator()(const f32x4 (&acc)[2][2][4][2], const Unit& u, int wr, int wc, int fr, int fq) const {
        const bool lat = u.pm < 64; const int s = lat ? (u.pm >> 3) : 8; const size_t r0 = (size_t)(lat ? u.pm : u.pm - 64) * BM;
        const bool whole = (u.nk == nk_full);
        float* xo = whole ? (lat ? x_l : x_c) + r0 * 1024 : part + ((size_t)u.pt * 2048 + r0) * 512;
        const float* xi = (lat ? xin_l : xin_c) + r0 * 1024;
        const int col0 = u.pn * BM + wc * 32 + 4 * fq;
        f32x4 gv[2][2];
#pragma unroll
        for (int bj = 0; bj < 2; ++bj)
#pragma unroll
            for (int n = 0; n < 2; ++n) gv[bj][n] = *(const f32x4*)(gate + s * 9216 + col0 + bj * HALF + n * 16) * gs;
        if (whole) {
#pragma unroll
            for (int ai = 0; ai < 2; ++ai)
#pragma unroll
                for (int m = 0; m < 4; ++m) { const unsigned off = (unsigned)(ai * HALF + wr * 64 + m * 16 + fr) * 1024u + (unsigned)col0;
#pragma unroll
                    for (int bj = 0; bj < 2; ++bj)
#pragma unroll
                        for (int n = 0; n < 2; ++n) { const f32x4 x = *(const f32x4*)(xi + off + bj * HALF + n * 16);
                            *(f32x4*)(xo + off + bj * HALF + n * 16) = x + gv[bj][n] * acc[ai][bj][m][n]; } }
        } else {
#pragma unroll
            for (int ai = 0; ai < 2; ++ai)
#pragma unroll
                for (int m = 0; m < 4; ++m) { const unsigned off = (unsigned)(ai * HALF + wr * 64 + m * 16 + fr) * 1024u + (unsigned)col0;
#pragma unroll
                    for (int bj = 0; bj < 2; ++bj)
#pragma unroll
                        for (int n = 0; n < 2; ++n) { const f32x4 pv = gv[bj][n] * acc[ai][bj][m][n];
                            u32x2 w2; w2.x = cvt_pk_bf16_b(pv[0], pv[1]); w2.y = cvt_pk_bf16_b(pv[2], pv[3]);
                            *(u32x2*)((bf16_t*)xo + off + bj * HALF + n * 16) = w2; } }
        }
    }
    __device__ __forceinline__ void fused(const f32x4 (&acc)[2][2][4][2], const Unit& u, int wr_, int wc_, int fr_, int fq_, PG8_LAS unsigned char* lds, int wid_, int lane_) const {
        const int tid2 = tid_now(), wid = __builtin_amdgcn_readfirstlane(tid2 >> 6), lane = tid2 & 63, wr = wid >> 2, wc = wid & 3, fr = lane & 15, fq = lane >> 4;
        const bool whole = (u.nk == nk_full);
        if (!fuse || !whole || u.pm >= 64) { (*this)(acc, u, wr, wc, fr, fq); return; }
        const int s = u.pm >> 3; float* xo = x_l + (size_t)u.pm * BM * 1024;
        const int col0 = u.pn * BM + wc * 32 + 4 * fq;
        PG8_LAS float* P = (PG8_LAS float*)lds;
        PG8_LAS float* S = (PG8_LAS float*)(lds + 8192);
        {   const float* gp = gate + s * 9216 + col0;
#pragma unroll
            for (int ai = 0; ai < 2; ++ai)
#pragma unroll
                for (int m = 0; m < 4; ++m) { const int r = ai * HALF + wr * 64 + m * 16 + fr; const unsigned eo = (unsigned)(u.pm * BM + r) * 1024u + (unsigned)col0;
                    float* xr = x_l + eo; const float* xir = xin_l + eo; float q = 0.f;
#pragma unroll
                    for (int bj = 0; bj < 2; ++bj)
#pragma unroll
                        for (int n = 0; n < 2; ++n) { const f32x4 x = *(const f32x4*)(xir + bj * HALF + n * 16); const f32x4 gvv = *(const f32x4*)(gp + bj * HALF + n * 16) * gs;
                            const f32x4 y = x + gvv * acc[ai][bj][m][n];
                            *(f32x4*)(xr + bj * HALF + n * 16) = y;
                            q += (y[0] * y[0] + y[1] * y[1]) + (y[2] * y[2] + y[3] * y[3]); }
                    q += __shfl_xor(q, 16); q += __shfl_xor(q, 32);
                    if (fq == 0) P[r * 4 + wc] = q;
                    asm volatile("" ::: "memory"); }
        }
        asm volatile("s_waitcnt lgkmcnt(0)" ::: "memory"); __builtin_amdgcn_s_barrier(); asm volatile("" ::: "memory");
        const int tid = wid * 64 + lane;
        if (tid < 256) { const float t = (P[tid * 4 + 0] + P[tid * 4 + 1]) + (P[tid * 4 + 2] + P[tid * 4 + 3]);
            __hip_atomic_store(slots + ((size_t)(u.pm * BM + tid) * 4 + u.pn), t, __ATOMIC_RELAXED, __HIP_MEMORY_SCOPE_AGENT); }
        asm volatile("s_waitcnt vmcnt(0)" ::: "memory");
        if (tid < 256 && lane == 0) __hip_atomic_fetch_add(cnt + 16 * u.pm, 1u, __ATOMIC_RELAXED, __HIP_MEMORY_SCOPE_AGENT);
        if (wid == 0) { unsigned spins = 0;
            while ((unsigned)__builtin_amdgcn_readfirstlane((int)__hip_atomic_load(cnt + 16 * u.pm, __ATOMIC_RELAXED, __HIP_MEMORY_SCOPE_AGENT)) < 16u) { __builtin_amdgcn_s_sleep(2); if (++spins > (1u << 22)) break; }
            __builtin_amdgcn_fence(__ATOMIC_ACQUIRE, "agent"); }
        asm volatile("s_waitcnt vmcnt(0) lgkmcnt(0)" ::: "memory"); __builtin_amdgcn_s_barrier(); asm volatile("" ::: "memory");
        if (tid < 256) { const float* sp = slots + (size_t)(u.pm * BM + tid) * 4; float t = 0.f;
#pragma unroll
            for (int k = 0; k < 4; ++k) t += __hip_atomic_load(sp + k, __ATOMIC_RELAXED, __HIP_MEMORY_SCOPE_AGENT);
            S[tid] = 1.0f / sqrtf(t * (1.0f / 1024.0f) + 1e-6f); }
        asm volatile("s_waitcnt vmcnt(0) lgkmcnt(0)" ::: "memory"); __builtin_amdgcn_s_barrier(); asm volatile("" ::: "memory");
        if (final) {
            f32x4 gg[2][2];
#pragma unroll
            for (int bj = 0; bj < 2; ++bj)
#pragma unroll
                for (int n = 0; n < 2; ++n) gg[bj][n] = *(const f32x4*)(nsh + col0 + bj * HALF + n * 16);
#pragma unroll
            for (int ai = 0; ai < 2; ++ai)
#pragma unroll
                for (int m = 0; m < 4; ++m) { const int r = ai * HALF + wr * 64 + m * 16 + fr; const float rr = S[r]; const size_t off = (size_t)r * 1024 + col0;
#pragma unroll
                    for (int bj = 0; bj < 2; ++bj)
#pragma unroll
                        for (int n = 0; n < 2; ++n) { const f32x4 y = *(const f32x4*)(xo + off + bj * HALF + n * 16); *(f32x4*)(xo + off + bj * HALF + n * 16) = y * rr * gg[bj][n]; }
                    asm volatile("" ::: "memory"); }
        } else {
            const float* shp = nsh + s * 9216 + col0; bf16_t* hb = H + (size_t)u.pm * BM * 1024 + col0;
            f32x4 sh[2][2], sc[2][2];
#pragma unroll
            for (int bj = 0; bj < 2; ++bj)
#pragma unroll
                for (int n = 0; n < 2; ++n) { sh[bj][n] = *(const f32x4*)(shp + bj * HALF + n * 16); sc[bj][n] = *(const f32x4*)(shp + 1024 + bj * HALF + n * 16) + 1.0f; }
#pragma unroll
            for (int ai = 0; ai < 2; ++ai)
#pragma unroll
                for (int m = 0; m < 4; ++m) { const int r = ai * HALF + wr * 64 + m * 16 + fr; const float rr = S[r];
#pragma unroll
                    for (int bj = 0; bj < 2; ++bj)
#pragma unroll
                        for (int n = 0; n < 2; ++n) { const f32x4 y = *(const f32x4*)(xo + (size_t)r * 1024 + col0 + bj * HALF + n * 16); const f32x4 o = y * rr * sc[bj][n] + sh[bj][n];
                            *(unsigned long long*)(hb + (size_t)r * 1024 + bj * HALF + n * 16) = (unsigned long long)cvt_pk_bf16(o[0], o[1]) | ((unsigned long long)cvt_pk_bf16(o[2], o[3]) << 32); }
                    asm volatile("" ::: "memory"); }
        }
    }
};
struct EpiQKV {
    static constexpr bool PERM = true, AFTER_DRAIN = false;
    bf16_t* Qb; bf16_t* Kb; bf16_t* Vtb; const float* rope; const float* qng; const float* kng; PG8_LAS unsigned char* stage;
    __device__ __forceinline__ void operator()(const f32x4 (&acc)[2][2][4][2], const Unit& u, int wr, int wc, int fr, int fq) const {
        constexpr int POSN = 2304;
        const int lane = fq * 16 + fr;
        PG8_LAS unsigned char* slab = stage + (wr * 4 + wc) * 2560;
        const int ch = u.pn * 4 + wc;
        int mixer, kind, hh;
        if (ch < 16) { mixer = ch >> 3; const int cc = ch & 7; kind = cc < 4 ? 0 : (cc < 6 ? 1 : 2); hh = cc < 4 ? cc : (cc < 6 ? cc - 4 : cc - 6); }
        else { const int cc = (ch < 28) ? ch - 16 : ch - 28; mixer = (ch < 28) ? 2 : 3; kind = cc >> 2; hh = cc & 3; }
        const int kvbase = mixer == 0 ? 0 : (mixer == 1 ? 2 : (mixer == 2 ? 4 : 8));
        const bool lat = u.pm < 64; const int b = lat ? (u.pm >> 3) : (u.pm - 64); const int posbase = lat ? (u.pm & 7) * 256 : 2048;
        const bool t32 = (mixer == 3) && (kind < 2);
        int dof[2][2];
#pragma unroll
        for (int bj = 0; bj < 2; ++bj)
#pragma unroll
            for (int n = 0; n < 2; ++n) dof[bj][n] = t32 ? (32 * bj + 16 * (fq >> 1) + 8 * n + 4 * (fq & 1)) : (32 * bj + 16 * n + 4 * fq);
        if (kind == 2) {
            bf16_t* vb = Vtb + (size_t)((kvbase + hh) * 8 + b) * 64 * POSN + (size_t)(posbase + wr * 64) * 64 + lane * 16;
#pragma unroll
            for (int ai = 0; ai < 2; ++ai)
#pragma unroll
                for (int m = 0; m < 4; ++m) {
#pragma unroll
                    for (int bj = 0; bj < 2; ++bj)
#pragma unroll
                        for (int n = 0; n < 2; ++n) { const f32x4 v = acc[ai][bj][m][n]; const int d0 = dof[bj][n];
                            const unsigned w0 = cvt_pk_bf16(v[0], v[1]), w1 = cvt_pk_bf16(v[2], v[3]);
                            PG8_LAS bf16_t* sp = (PG8_LAS bf16_t*)(slab + d0 * 40 + fr * 2);
                            sp[0] = (bf16_t)(w0 & 0xffffu); sp[20] = (bf16_t)(w0 >> 16); sp[40] = (bf16_t)(w1 & 0xffffu); sp[60] = (bf16_t)(w1 >> 16); }
                    asm volatile("" ::: "memory");
                    typedef unsigned long long u64s;
                    const PG8_LAS u64s* rp = (const PG8_LAS u64s*)(slab + lane * 40);
                    const u64s r0 = rp[0], r1 = rp[1], r2 = rp[2], r3 = rp[3];
                    asm volatile("" ::: "memory");
                    bf16_t* dst = vb + (size_t)(ai * HALF + m * 16) * 64;
                    u32x4 o0, o1; o0.x = (unsigned)r0; o0.y = (unsigned)(r0 >> 32); o0.z = (unsigned)r1; o0.w = (unsigned)(r1 >> 32); o1.x = (unsigned)r2; o1.y = (unsigned)(r2 >> 32); o1.z = (unsigned)r3; o1.w = (unsigned)(r3 >> 32);
                    *(u32x4*)dst = o0; *(u32x4*)(dst + 8) = o1; }
            return;
        }
        const float qs = (kind == 0) ? ((mixer == 3 ? 0.17677669529663687f : 0.125f) * 1.44269504f) : 1.0f;
        bf16_t* ob = (kind == 0) ? Qb + (size_t)((mixer * 8 + b) * 4 + hh) * POSN * 64 : Kb + (size_t)((kvbase + hh) * 8 + b) * POSN * 64;
        f32x4 gv[2][2];
        if (mixer == 1) { const float* gp = (kind == 0) ? qng : kng;
#pragma unroll
            for (int bj = 0; bj < 2; ++bj)
#pragma unroll
                for (int n = 0; n < 2; ++n) gv[bj][n] = *(const f32x4*)(gp + dof[bj][n]); }
#pragma unroll
        for (int ai = 0; ai < 2; ++ai)
#pragma unroll
            for (int m = 0; m < 4; ++m) {
                const int pos = posbase + ai * HALF + wr * 64 + m * 16 + fr;
                f32x4 v[2][2];
#pragma unroll
                for (int bj = 0; bj < 2; ++bj)
#pragma unroll
                    for (int n = 0; n < 2; ++n) v[bj][n] = acc[ai][bj][m][n];
                if (mixer == 1) {
                    float ss = 0.f;
#pragma unroll
                    for (int bj = 0; bj < 2; ++bj)
#pragma unroll
                        for (int n = 0; n < 2; ++n) ss += (v[bj][n][0] * v[bj][n][0] + v[bj][n][1] * v[bj][n][1]) + (v[bj][n][2] * v[bj][n][2] + v[bj][n][3] * v[bj][n][3]);
                    ss += __shfl_xor(ss, 16); ss += __shfl_xor(ss, 32);
                    const float rr = 1.0f / sqrtf(ss * (1.0f / 64.0f) + 1e-6f);
#pragma unroll
                    for (int bj = 0; bj < 2; ++bj)
#pragma unroll
                        for (int n = 0; n < 2; ++n) v[bj][n] = v[bj][n] * rr * gv[bj][n];
                }
                if (lat && mixer < 2) {
                    const int grow = pos >> 6, gcol = pos & 63;
#pragma unroll
                    for (int bj = 0; bj < 2; ++bj) { const float* rp = rope + (bj ? gcol : grow) * 16 + 4 * fq;
                        const f32x4 c4 = *(const f32x4*)rp, s4 = *(const f32x4*)(rp + 1024);
                        const f32x4 x0 = v[bj][0], x1 = v[bj][1];
                        v[bj][0] = x0 * c4 - x1 * s4; v[bj][1] = x1 * c4 + x0 * s4; }
                } else if (lat && mixer == 3) {
                    const int p = (fq & 2) ? (pos & 63) : (pos >> 6);
                    const float* rp = rope + 2048 + p * 8 + 4 * (fq & 1); const f32x4 c4 = *(const f32x4*)rp, s4 = *(const f32x4*)(rp + 512);
#pragma unroll
                    for (int bj = 0; bj < 2; ++bj) { const f32x4 x0 = v[bj][0], x1 = v[bj][1];
                        v[bj][0] = x0 * c4 - x1 * s4; v[bj][1] = x1 * c4 + x0 * s4; }
                }
#pragma unroll
                for (int bj = 0; bj < 2; ++bj)
#pragma unroll
                    for (int n = 0; n < 2; ++n) { const f32x4 a = v[bj][n] * qs;
                        *(PG8_LAS unsigned long long*)(slab + fr * 136 + dof[bj][n] * 2) = (unsigned long long)cvt_pk_bf16(a[0], a[1]) | ((unsigned long long)cvt_pk_bf16(a[2], a[3]) << 32); }
                asm volatile("" ::: "memory");
                typedef unsigned long long u64s;
                const PG8_LAS u64s* rp = (const PG8_LAS u64s*)(slab + (lane >> 2) * 136 + (lane & 3) * 32);
                const u64s r0 = rp[0], r1 = rp[1], r2 = rp[2], r3 = rp[3];
                asm volatile("" ::: "memory");
                bf16_t* dst = ob + (size_t)(posbase + ai * HALF + wr * 64 + m * 16) * 64 + lane * 16;
                u32x4 o0, o1; o0.x = (unsigned)r0; o0.y = (unsigned)(r0 >> 32); o0.z = (unsigned)r1; o0.w = (unsigned)(r1 >> 32); o1.x = (unsigned)r2; o1.y = (unsigned)(r2 >> 32); o1.z = (unsigned)r3; o1.w = (unsigned)(r3 >> 32);
                *(u32x4*)dst = o0; *(u32x4*)(dst + 8) = o1;
            }
    }
};
struct SplitOrder {
    StaticOrder so; int P;
    __host__ __device__ void init(int M, int N, int G_, int c_, int K_) {
        P = (M == 18432 && N == 1024 && G_ == 256 && (K_ / BK) >= 16) ? 8 : 0;
#ifdef NO_SPLIT
        P = 0;
#endif
        so.init(P ? 16384 : M, N, G_, c_, K_);
    }
    __host__ __device__ bool next(int i, Unit& u) const {
        Unit a; a.pm = 0; a.pn = 0; a.k0 = 0; a.nk = so.nK; a.pt = 0;
        bool ok;
        if (P == 0) ok = so.next(i, a);
        else {
            ok = so.next(0, a) && (i <= 1);
            if (i == 0) {
                const int t = so.c >> 3, p = so.c & 7, h = so.nK / 2, q = h / P, r = h % P;
                a.pm = 64 + (t >> 2); a.pn = t & 3; a.pt = p;
                a.k0 = 2 * (p * q + (p < r ? p : r)); a.nk = 2 * (q + (p < r ? 1 : 0));
            }
        }
        u = a; return ok;
    }
    __device__ __forceinline__ void a_ready(const Unit&) const {}
    __device__ __forceinline__ void done(const Unit&) const {}
};
}

#define LAS __attribute__((address_space(3)))
typedef unsigned short bf16_t;
typedef short bf16x8 __attribute__((ext_vector_type(8)));
typedef float f32x4 __attribute__((ext_vector_type(4)));
typedef unsigned u32x4 __attribute__((ext_vector_type(4)));
typedef unsigned u32x2 __attribute__((ext_vector_type(2)));
constexpr int NT = 512;
constexpr int DM = 1024, SEQ = 2048, NBATCH = 8, CTXL = 256, DFF = 2816, INW = 2560;
constexpr int ML = NBATCH * SEQ, MC = NBATCH * CTXL, MT = ML + MC;
constexpr int POS = SEQ + CTXL;
constexpr float LOG2E = 1.44269504f;
constexpr int LDS_BYTES = 152576;
#ifndef REP_SYNC
#define REP_SYNC 1
#endif
#define GSYNC() do { for (int r_ = 0; r_ < REP_SYNC; ++r_) { XcdBarrier xb_; xb_.bar = (unsigned*)(ldws() + WS_BAR); xb_.x = xb_xcc_id(); xb_.st = (volatile LAS unsigned*)(lds + MISC_OFF); xcd_barrier(xb_); } } while (0)
constexpr int MISC_OFF = LDS_BYTES - 64;
#ifdef NO_SPLIT
#define SPLIT_PART ((const float*)nullptr)
#else
#define SPLIT_PART ((GRD == 256) ? (const float*)WSF(WS_Q) : (const float*)nullptr)
#endif
#ifndef REP_ATT
#define REP_ATT 1
#endif
#ifndef REP_LIGHT
#define REP_LIGHT 1
#endif
#ifndef REP_GU
#define REP_GU 1
#endif
constexpr size_t MiB = 1u << 20;
constexpr size_t WS_CTL = 0, WS_BAR = 16384, WS_CNT = 32768, CTL_ZERO_BYTES = 65536, WS_ROPE = 65536, WS_SCAL = 131072, WS_MOD = 262144;
constexpr size_t WS_W = 1 * MiB;
constexpr size_t W_GU1 = 0, W_D1 = 11 * MiB, W_IN = 16 * MiB + 512 * 1024, W_OUT = 21 * MiB + 512 * 1024, W_GU2 = 23 * MiB + 512 * 1024, W_D2 = 34 * MiB + 512 * 1024;
constexpr size_t WS_XC = 41 * MiB, WS_H = 49 * MiB, WS_G = 85 * MiB, WS_Q = 184 * MiB, WS_K = 220 * MiB, WS_VT = 247 * MiB, WS_SLOTS = 274 * MiB, WS_END = 275 * MiB;

__device__ __forceinline__ float bf2f(bf16_t v) { return __builtin_bit_cast(float, (unsigned)v << 16); }
__device__ __forceinline__ unsigned pk2(float lo, float hi) { return pg8::cvt_pk_bf16(lo, hi); }
__device__ __forceinline__ bf16_t f2bf(float v) { return (bf16_t)(pk2(v, 0.f) & 0xffffu); }
__device__ __forceinline__ float wave_sum(float v) {
#pragma unroll
    for (int o = 1; o < 64; o <<= 1) v += __shfl_xor(v, o);
    return v;
}
#define LDS_WAIT() asm volatile("s_waitcnt lgkmcnt(0)" ::: "memory")
#define XB_TMO      128
#define XB_XCNT(j)  (256  + 64 * (j))
#define XB_XSUB(j)  (1280 + 64 * (j))
#define XB_XGEN(j)  (2304 + 64 * (j))
#define XB_TOP      3328
#define XB_TOPGEN   3392
#define XCD_BAR_WORDS 3456
#define XB_SPIN_CAP (1u << 18)

__device__ __forceinline__ unsigned xb_ld(unsigned* p)              { return __hip_atomic_load(p, __ATOMIC_RELAXED, __HIP_MEMORY_SCOPE_AGENT); }
__device__ __forceinline__ unsigned xb_add(unsigned* p, unsigned v) { return __hip_atomic_fetch_add(p, v, __ATOMIC_RELAXED, __HIP_MEMORY_SCOPE_AGENT); }
__device__ __forceinline__ unsigned xb_xcc_id() { return (unsigned)__builtin_amdgcn_s_getreg((3 << 11) | 20) & 0xFu; }
#define XB_SPIN(cond, bar) do { unsigned _sp = 0; while (cond) { __builtin_amdgcn_s_sleep(1); \
    if ((++_sp & 255u) == 0u) { if (xb_ld(&(bar)[XB_TMO])) break; if (_sp > XB_SPIN_CAP) { atomicAdd(&(bar)[XB_TMO], 1u); break; } } } } while (0)

struct XcdBarrier {
    unsigned* bar; unsigned x;
    volatile LAS unsigned* st;
};

__device__ __forceinline__ XcdBarrier xcd_barrier_post(unsigned* bar, volatile LAS unsigned* st) {
    XcdBarrier b; b.bar = bar; b.x = xb_xcc_id(); b.st = st;
    if (threadIdx.x == 0) (void)xb_add(&bar[XB_XCNT(b.x)], 1u);
    return b;
}
__device__ __forceinline__ void xcd_barrier_complete(unsigned* bar, unsigned x, unsigned& nloc, unsigned& nx) {
    const unsigned G = gridDim.x * gridDim.y * gridDim.z;
    unsigned sum, cnt, mine, sp = 0u;
    for (;;) {
        sum = 0u; cnt = 0u; mine = 0u;
#pragma unroll
        for (unsigned j = 0; j < 16; ++j) { const unsigned c = xb_ld(&bar[XB_XCNT(j)]); sum += c; cnt += (c > 0u) ? 1u : 0u; mine = (j == x) ? c : mine; }
        if (sum == G) break;
        __builtin_amdgcn_s_sleep(1);
        if ((++sp & 255u) == 0u) { if (xb_ld(&bar[XB_TMO])) break; if (sp > XB_SPIN_CAP) { atomicAdd(&bar[XB_TMO], 1u); break; } }
    }
    nloc = mine > 0u ? mine : 1u; nx = cnt > 0u ? cnt : 1u;
}

__device__ __forceinline__ void xcd_barrier(const XcdBarrier& b) {
    asm volatile("s_waitcnt vmcnt(0)" ::: "memory");
    __syncthreads();
    if (threadIdx.x == 0) {
        unsigned* bar = b.bar;
        __builtin_amdgcn_s_waitcnt(0);
        unsigned nloc = b.st[0], nx = b.st[1];
        if (nloc == 0u) { xcd_barrier_complete(bar, b.x, nloc, nx); b.st[0] = nloc; b.st[1] = nx; }
        const unsigned old = xb_add(&bar[XB_XSUB(b.x)], 1u);
        const unsigned gen = old / nloc;
        if (old + 1u == (gen + 1u) * nloc) {
            __builtin_amdgcn_fence(__ATOMIC_RELEASE, "agent");
            asm volatile("s_waitcnt vmcnt(0)" ::: "memory");
            const unsigned og = xb_add(&bar[XB_TOP], 1u);
            const unsigned tg = og / nx;
            if (og + 1u == (tg + 1u) * nx) xb_add(&bar[XB_TOPGEN], 1u);
            else XB_SPIN(xb_ld(&bar[XB_TOPGEN]) == tg, bar);
            __builtin_amdgcn_fence(__ATOMIC_ACQUIRE, "agent");
            xb_add(&bar[XB_XGEN(b.x)], 1u);
            asm volatile("s_waitcnt vmcnt(0)" ::: "memory");
        } else {
            XB_SPIN(xb_ld(&bar[XB_XGEN(b.x)]) == gen, bar);
            __builtin_amdgcn_fence(__ATOMIC_ACQUIRE, "agent");
            asm volatile("s_waitcnt vmcnt(0)" ::: "memory");
        }
    }
    __syncthreads();
}


__device__ __forceinline__ void p0_mod(LAS unsigned char* lds, const float* c, const float* cctx, const float* w_ada, const float* b_ada, float* MOD, int bid, int G, int tid) {
    LAS float* sl = (LAS float*)lds;
    LAS float* red = (LAS float*)(lds + 36864);
    for (int i = tid; i < 9 * 1024; i += NT) { const float v = i < 8192 ? c[i] : cctx[i - 8192]; sl[i] = v / (1.0f + expf(-v)); }
    __syncthreads();
    const int col = tid & 63, kg = tid >> 6;
    for (int item = bid; item < 2 * 144; item += G) {
        const int l = item / 144, n0 = (item % 144) * 64;
        const float* w = w_ada + (size_t)l * 1024 * 9216 + n0 + col;
        float acc[9];
#pragma unroll
        for (int s = 0; s < 9; ++s) acc[s] = 0.f;
#pragma unroll 16
        for (int k = kg * 128; k < kg * 128 + 128; ++k) { const float wv = __builtin_nontemporal_load(&w[(size_t)k * 9216]);
#pragma unroll
            for (int s = 0; s < 9; ++s) acc[s] += sl[s * 1024 + k] * wv; }
#pragma unroll
        for (int s = 0; s < 9; ++s) red[(kg * 9 + s) * 64 + col] = acc[s];
        __syncthreads();
        for (int i = tid; i < 9 * 64; i += NT) { const int s = i >> 6, cc = i & 63; float v = b_ada[l * 9216 + n0 + cc];
#pragma unroll
            for (int g = 0; g < 8; ++g) v += red[(g * 9 + s) * 64 + cc];
            MOD[((size_t)l * 9 + s) * 9216 + n0 + cc] = v; }
        __syncthreads();
    }
}
__device__ __forceinline__ void p0_misc(float* rope, float* scal, const float* lq1, const float* lk1, const float* lq2, const float* lk2, int tid) {
    for (int i = tid; i < 1024; i += NT) { const int p = i >> 4, f = i & 15; const float fr = exp2f(-(float)f * (13.287712379549449f / 16.0f)); const float a = (float)p * fr; rope[i] = __cosf(a); rope[1024 + i] = __sinf(a); }
    for (int i = tid; i < 512; i += NT) { const int p = i >> 3, f = i & 7; const float fr = exp2f(-(float)f * (13.287712379549449f / 8.0f)); const float a = (float)p * fr; rope[2048 + i] = __cosf(a); rope[2560 + i] = __sinf(a); }
    if (tid < 2) { const int l = tid; float d1 = 0.f, d2 = 0.f;
        for (int k = 0; k < 32; ++k) { d1 += lq1[l * 32 + k] * lk1[l * 32 + k]; d2 += lq2[l * 32 + k] * lk2[l * 32 + k]; }
        const float lam_init = 0.8f - 0.6f * expf(-0.3f * (float)l);
        scal[l] = expf(d1) - expf(d2) + lam_init; }
}

__device__ __forceinline__ void transpose_item(const float* W, int K, int N, bf16_t* WT, int mode, LAS float* scr, int item, int lane) {
    const int nblk = N / 32, kb = item / nblk, nb = item % nblk, k0 = 64 * kb, n0 = 32 * nb;
    const int g8 = (n0 >> 5) & 7;
    const int drow0 = mode == 0 ? n0 : (mode == 3 ? ((n0 & ~255) + 32 * (4 * (g8 & 1) + (g8 >> 1))) : ((n0 >> 7) * 256 + (n0 & 127) + (mode == 2 ? 128 : 0)));
    float wv[32];
#pragma unroll
    for (int i = 0; i < 32; ++i) wv[i] = __builtin_nontemporal_load(&W[(size_t)(k0 + 2 * i + (lane >> 5)) * N + n0 + (lane & 31)]);
#pragma unroll
    for (int i = 0; i < 32; ++i) scr[(2 * i + (lane >> 5)) * 33 + (lane & 31)] = wv[i];
    LDS_WAIT(); asm volatile("" ::: "memory");
    const int c = lane & 7;
#pragma unroll
    for (int j = 0; j < 4; ++j) { const int n = (lane >> 3) + 8 * j; const LAS float* s = scr + (8 * c) * 33 + n;
        u32x4 o; o.x = pk2(s[0 * 33], s[1 * 33]); o.y = pk2(s[2 * 33], s[3 * 33]); o.z = pk2(s[4 * 33], s[5 * 33]); o.w = pk2(s[6 * 33], s[7 * 33]);
        int nn = n;
        if (mode == 3) { const bool t32 = (n0 >> 6) >= 28 && (n0 >> 6) < 36;
            nn = t32 ? (8 * (2 * ((n >> 4) & 1) + ((n >> 2) & 1)) + 4 * ((n >> 3) & 1) + (n & 3)) : (8 * ((n >> 2) & 3) + 4 * (n >> 4) + (n & 3)); }
        *(u32x4*)(WT + (size_t)(drow0 + nn) * K + k0 + 8 * c) = o; }
    LDS_WAIT(); asm volatile("" ::: "memory");
}
__device__ __forceinline__ void convert_layer(LAS unsigned char* lds, int l, const float* g1, const float* u1, const float* d1, const float* win, const float* wout,
                                              const float* g2, const float* u2, const float* d2, unsigned char* wsW, int gw, int NGW, int wave, int lane) {
    LAS float* scr = (LAS float*)(lds + wave * 8448);
    const size_t offF = (size_t)l * DM * DFF;
    constexpr int I_GU = 16 * 88, I_D = 44 * 32, I_IN = 16 * 80, I_OUT = 16 * 32;
    constexpr int NITEMS = 6 * I_GU + I_IN + I_OUT;
    for (int it = gw; it < NITEMS; it += NGW) {
        int r = it;
        if (r < I_GU) { transpose_item(g1 + offF, DM, DFF, (bf16_t*)(wsW + W_GU1), 1, scr, r, lane); continue; } r -= I_GU;
        if (r < I_GU) { transpose_item(u1 + offF, DM, DFF, (bf16_t*)(wsW + W_GU1), 2, scr, r, lane); continue; } r -= I_GU;
        if (r < I_D)  { transpose_item(d1 + offF, DFF, DM, (bf16_t*)(wsW + W_D1), 0, scr, r, lane); continue; } r -= I_D;
        if (r < I_GU) { transpose_item(g2 + offF, DM, DFF, (bf16_t*)(wsW + W_GU2), 1, scr, r, lane); continue; } r -= I_GU;
        if (r < I_GU) { transpose_item(u2 + offF, DM, DFF, (bf16_t*)(wsW + W_GU2), 2, scr, r, lane); continue; } r -= I_GU;
        if (r < I_D)  { transpose_item(d2 + offF, DFF, DM, (bf16_t*)(wsW + W_D2), 0, scr, r, lane); continue; } r -= I_D;
        if (r < I_IN) { transpose_item(win + (size_t)l * DM * INW, DM, INW, (bf16_t*)(wsW + W_IN), 3, scr, r, lane); continue; } r -= I_IN;
        transpose_item(wout + (size_t)l * DM * DM, DM, DM, (bf16_t*)(wsW + W_OUT), 0, scr, r, lane);
    }
}

__device__ __forceinline__ void norm_mod_row(const float* xr, float* cp, bf16_t* hrow, const float* sh, const float* sc, int lane) {
    f32x4 v[4]; float ss = 0.f;
#pragma unroll
    for (int j = 0; j < 4; ++j) { v[j] = *(const f32x4*)(xr + 4 * lane + 256 * j); ss += (v[j].x * v[j].x + v[j].y * v[j].y) + (v[j].z * v[j].z + v[j].w * v[j].w); }
    if (cp) {
#pragma unroll
        for (int j = 0; j < 4; ++j) *(f32x4*)(cp + 4 * lane + 256 * j) = v[j];
    }
    ss = wave_sum(ss);
    const float rr = 1.0f / sqrtf(ss * (1.0f / DM) + 1e-6f);
    unsigned long long* o8 = (unsigned long long*)hrow + lane;
#pragma unroll
    for (int j = 0; j < 4; ++j) { const f32x4 a = *(const f32x4*)(sh + 4 * lane + 256 * j), b = *(const f32x4*)(sc + 4 * lane + 256 * j);
        const f32x4 o = v[j] * rr * (b + 1.0f) + a;
        o8[64 * j] = (unsigned long long)pk2(o.x, o.y) | ((unsigned long long)pk2(o.z, o.w) << 32); }
}
__device__ __forceinline__ void norm_mod_phase(const float* xl, const float* xc, float* cpl, float* cpc, const float* part, float* xcw, bf16_t* H, const float* modl, int sidx, int rbegin, int nrows, int gw, int ngw, int lane) {
    for (int r = rbegin + gw; r < nrows; r += 2 * ngw) {
        const int r2 = r + ngw; const bool two = r2 < nrows;
        const bool lat = r < ML; const size_t ro = lat ? (size_t)r * DM : (size_t)(r - ML) * DM; const int s = lat ? (r >> 11) : 8;
        const float* sh = modl + s * 9216 + sidx * 1024;
        const bool lat2 = r2 < ML; const size_t ro2 = lat2 ? (size_t)r2 * DM : (size_t)(r2 - ML) * DM; const int s2 = lat2 ? (r2 >> 11) : 8;
        const float* sh2 = modl + s2 * 9216 + sidx * 1024;
        const float* xr = (lat ? xl : xc) + ro; const float* xr2 = (lat2 ? xl : xc) + ro2;
        f32x4 v[4], w[4]; float ss = 0.f, ss2 = 0.f;
#pragma unroll
        for (int j = 0; j < 4; ++j) { v[j] = *(const f32x4*)(xr + 4 * lane + 256 * j); }
        if (two) {
#pragma unroll
            for (int j = 0; j < 4; ++j) { w[j] = *(const f32x4*)(xr2 + 4 * lane + 256 * j); }
        } else {
#pragma unroll
            for (int j = 0; j < 4; ++j) w[j] = (f32x4){0.f, 0.f, 0.f, 0.f};
        }
        if (part && !lat) {
#pragma unroll
            for (int p = 0; p < 8; ++p) { const bf16_t* pp = (const bf16_t*)part + (size_t)p * 2048 * 1024 + ro;
#pragma unroll
                for (int j = 0; j < 4; ++j) { const u32x2 q = __builtin_nontemporal_load((const u32x2*)(pp + 4 * lane + 256 * j));
                    v[j] += (f32x4){__builtin_bit_cast(float, q.x << 16), __builtin_bit_cast(float, q.x & 0xffff0000u), __builtin_bit_cast(float, q.y << 16), __builtin_bit_cast(float, q.y & 0xffff0000u)}; } }
            float* cp = xcw + ro;
#pragma unroll
            for (int j = 0; j < 4; ++j) *(f32x4*)(cp + 4 * lane + 256 * j) = v[j];
        }
        if (part && two && !lat2) {
#pragma unroll
            for (int p = 0; p < 8; ++p) { const bf16_t* pp = (const bf16_t*)part + (size_t)p * 2048 * 1024 + ro2;
#pragma unroll
                for (int j = 0; j < 4; ++j) { const u32x2 q = __builtin_nontemporal_load((const u32x2*)(pp + 4 * lane + 256 * j));
                    w[j] += (f32x4){__builtin_bit_cast(float, q.x << 16), __builtin_bit_cast(float, q.x & 0xffff0000u), __builtin_bit_cast(float, q.y << 16), __builtin_bit_cast(float, q.y & 0xffff0000u)}; } }
            float* cp = xcw + ro2;
#pragma unroll
            for (int j = 0; j < 4; ++j) *(f32x4*)(cp + 4 * lane + 256 * j) = w[j];
        }
#pragma unroll
        for (int j = 0; j < 4; ++j) { ss += (v[j].x * v[j].x + v[j].y * v[j].y) + (v[j].z * v[j].z + v[j].w * v[j].w); ss2 += (w[j].x * w[j].x + w[j].y * w[j].y) + (w[j].z * w[j].z + w[j].w * w[j].w); }
        if (cpl) { float* cp = (lat ? cpl : cpc) + ro;
#pragma unroll
            for (int j = 0; j < 4; ++j) *(f32x4*)(cp + 4 * lane + 256 * j) = v[j];
            if (two) { float* cp2 = (lat2 ? cpl : cpc) + ro2;
#pragma unroll
                for (int j = 0; j < 4; ++j) *(f32x4*)(cp2 + 4 * lane + 256 * j) = w[j]; } }
#pragma unroll
        for (int o = 1; o < 64; o <<= 1) { ss += __shfl_xor(ss, o); ss2 += __shfl_xor(ss2, o); }
        const float rr = 1.0f / sqrtf(ss * (1.0f / DM) + 1e-6f), rr2 = 1.0f / sqrtf(ss2 * (1.0f / DM) + 1e-6f);
        unsigned long long* o8 = (unsigned long long*)(H + (size_t)r * DM) + lane;
#pragma unroll
        for (int j = 0; j < 4; ++j) { const f32x4 a = *(const f32x4*)(sh + 4 * lane + 256 * j), b = *(const f32x4*)(sh + 1024 + 4 * lane + 256 * j);
            const f32x4 o = v[j] * rr * (b + 1.0f) + a;
            o8[64 * j] = (unsigned long long)pk2(o.x, o.y) | ((unsigned long long)pk2(o.z, o.w) << 32); }
        if (two) { unsigned long long* p8 = (unsigned long long*)(H + (size_t)r2 * DM) + lane;
#pragma unroll
            for (int j = 0; j < 4; ++j) { const f32x4 a = *(const f32x4*)(sh2 + 4 * lane + 256 * j), b = *(const f32x4*)(sh2 + 1024 + 4 * lane + 256 * j);
                const f32x4 o = w[j] * rr2 * (b + 1.0f) + a;
                p8[64 * j] = (unsigned long long)pk2(o.x, o.y) | ((unsigned long long)pk2(o.z, o.w) << 32); } }
    }
}
__device__ __forceinline__ void final_norm_phase(float* x, const float* g, int gw, int NGW, int lane) {
    for (int r = gw; r < ML; r += NGW) {
        float* xr = x + (size_t)r * DM;
        f32x4 v[4]; float ss = 0.f;
#pragma unroll
        for (int j = 0; j < 4; ++j) { v[j] = *(const f32x4*)(xr + 4 * lane + 256 * j); ss += (v[j].x * v[j].x + v[j].y * v[j].y) + (v[j].z * v[j].z + v[j].w * v[j].w); }
        ss = wave_sum(ss);
        const float rr = 1.0f / sqrtf(ss * (1.0f / DM) + 1e-6f);
#pragma unroll
        for (int j = 0; j < 4; ++j) { const f32x4 a = *(const f32x4*)(g + 4 * lane + 256 * j); *(f32x4*)(xr + 4 * lane + 256 * j) = v[j] * rr * a; }
    }
}

__device__ __forceinline__ void qkv_post_phase(LAS unsigned char* lds, const bf16_t* QKV, bf16_t* Qb, bf16_t* Kb, bf16_t* Vtb, const float* rope, const float* qng, const float* kng,
                                               int bid, int G, int tid, int lane, int wave) {
    LAS bf16_t* T = (LAS bf16_t*)lds;
    const float qg = qng[lane], kg = kng[lane];
    for (int item = bid; item < MT / 32; item += G) {
        const int row0 = item * 32; const bool lat = row0 < ML;
        const int b = lat ? (row0 >> 11) : ((row0 - ML) >> 8);
        const int pos0 = lat ? (row0 & 2047) : 2048 + ((row0 - ML) & 255);
        for (int rr = 0; rr < 4; ++rr) {
            const int tl = wave * 4 + rr, row = row0 + tl, pos = pos0 + tl;
            const int grow = (pos >> 6) & 31, gcol = pos & 63;
            const bf16_t* src = QKV + (size_t)row * INW + lane;
            const int p64 = (lane < 32) ? grow : gcol; const float c64 = rope[p64 * 16 + (lane & 15)], s64 = rope[1024 + p64 * 16 + (lane & 15)];
            const int p32 = (lane & 16) ? gcol : grow; const float c32 = rope[2048 + p32 * 8 + (lane & 7)], s32 = rope[2560 + p32 * 8 + (lane & 7)];
#pragma unroll 1
            for (int ch = 0; ch < 40; ++ch) {
                int mixer, kind, hh;
                if (ch < 16) { mixer = ch >> 3; const int cc = ch & 7; kind = cc < 4 ? 0 : (cc < 6 ? 1 : 2); hh = cc < 4 ? cc : (cc < 6 ? cc - 4 : cc - 6); }
                else { const int cc = (ch < 28) ? ch - 16 : ch - 28; mixer = (ch < 28) ? 2 : 3; kind = cc >> 2; hh = cc & 3; }
                const int kvbase = mixer == 0 ? 0 : (mixer == 1 ? 2 : (mixer == 2 ? 4 : 8));
                const bf16_t raw = src[ch * 64];
                if (kind == 2) { T[((kvbase + hh) * 64 + lane) * 34 + tl] = raw; continue; }
                float v = bf2f(raw);
                if (mixer == 1) { const float ss = wave_sum(v * v); v = v * (1.0f / sqrtf(ss * (1.0f / 64.0f) + 1e-6f)) * (kind == 0 ? qg : kg); }
                if (lat && mixer < 2) { const float pr = __shfl_xor(v, 16); v = v * c64 + ((lane & 16) ? pr : -pr) * s64; }
                else if (lat && mixer == 3) { const float pr = __shfl_xor(v, 8); v = v * c32 + ((lane & 8) ? pr : -pr) * s32; }
                if (kind == 0) { v *= (mixer == 3 ? 0.17677669529663687f : 0.125f) * LOG2E;
                    Qb[((size_t)((mixer * 8 + b) * 4 + hh) * POS + pos) * 64 + lane] = f2bf(v); }
                else Kb[((size_t)((kvbase + hh) * 8 + b) * POS + pos) * 64 + lane] = f2bf(v);
            }
        }
        __syncthreads();
#pragma unroll 1
        for (int p = 0; p < 6; ++p) { const int task = p * NT + tid, rowi = task >> 2, k = task & 3; const int c12 = rowi >> 6, d = rowi & 63;
            const LAS bf16_t* s = T + rowi * 34 + 8 * k;
            u32x4 o; o.x = (unsigned)s[0] | ((unsigned)s[1] << 16); o.y = (unsigned)s[2] | ((unsigned)s[3] << 16); o.z = (unsigned)s[4] | ((unsigned)s[5] << 16); o.w = (unsigned)s[6] | ((unsigned)s[7] << 16);
            *(u32x4*)(Vtb + ((size_t)(c12 * 8 + b) * 64 + d) * POS + pos0 + 8 * k) = o; }
        __syncthreads();
    }
}

#define MFMA16(a, b, c) __builtin_amdgcn_mfma_f32_16x16x32_bf16(a, b, c, 0, 0, 0)
constexpr int KSTR = 72;
constexpr int ABUF_BYTES = 2 * 64 * KSTR * 2;
constexpr int ATT_BIAS_OFF = 2 * ABUF_BYTES, ATT_CUR_OFF = ATT_BIAS_OFF + 2048;
constexpr float RESCALE_TH = 8.0f;
typedef float f32x2_t __attribute__((ext_vector_type(2)));
typedef __bf16 bf16x2_t __attribute__((ext_vector_type(2)));
__device__ __forceinline__ unsigned pk2v(float lo, float hi) { f32x2_t v = {lo, hi}; bf16x2_t b = __builtin_convertvector(v, bf16x2_t); return __builtin_bit_cast(unsigned, b); }
__device__ __forceinline__ float max3f(float a, float b, float c) { float r; asm("v_max3_f32 %0, %1, %2, %3" : "=v"(r) : "v"(a), "v"(b), "v"(c)); return r; }

template <bool DIFF>
__device__ __forceinline__ void attn_unit(LAS unsigned char* lds, const bf16_t* __restrict__ Qp, const bf16_t* __restrict__ Kp, const bf16_t* __restrict__ Vp, bf16_t* __restrict__ Yp,
                                          int q0, int ntiles, int nfirst, int firstpos, int secondpos, int maskmode, float m_init, bool sinkf, const LAS float* bias,
                                          float lam, const float* subg, float oscale, int wave) {
    constexpr int NB = DIFF ? 2 : 1;
    const int tid = tid_now(), lane = tid & 63;
    const int fr = lane & 15, fq = lane >> 4;
    const int sr = tid >> 3, sc = (tid & 7) * 8;
    const int vgo = tid * 8;
    const unsigned vst = 9216u + (unsigned)((((tid >> 1) & 63) * KSTR) + (tid >> 7) * 16 + (tid & 1) * 8) * 2u;
    const int qbase = q0 + wave * 32 + fr;
    bf16x8 qf[2][2];
#pragma unroll
    for (int qg = 0; qg < 2; ++qg) { qf[qg][0] = __builtin_nontemporal_load((const bf16x8*)(Qp + (size_t)(qbase + 16 * qg) * 64 + fq * 8)); qf[qg][1] = __builtin_nontemporal_load((const bf16x8*)(Qp + (size_t)(qbase + 16 * qg) * 64 + 32 + fq * 8)); }
    f32x4 o[2][NB][4], l[2][NB]; float m[2][NB];
    const bf16x8 ones = (bf16x8){16256, 16256, 16256, 16256, 16256, 16256, 16256, 16256};
#pragma unroll
    for (int qg = 0; qg < 2; ++qg)
#pragma unroll
        for (int br = 0; br < NB; ++br) { m[qg][br] = (br == 0) ? m_init : -1e30f; { const float l0 = (br == 0 && sinkf) ? 1.f : 0.f; l[qg][br] = (f32x4){l0, l0, l0, l0}; }
#pragma unroll
            for (int dg = 0; dg < 4; ++dg) o[qg][br][dg] = (f32x4){0.f, 0.f, 0.f, 0.f}; }
    const unsigned stoff = (unsigned)(sr * KSTR + sc) * 2u;
#define TILEPOS(t) (((t) < nfirst) ? firstpos + 64 * (t) : secondpos + 64 * ((t) - nfirst))
    u32x4 kA, vA, kB, vB;
    kB = *(const u32x4*)(Kp + (size_t)(firstpos + sr) * 64 + sc); vB = *(const u32x4*)(Vp + (size_t)firstpos * 64 + vgo);
    { const int p1 = (1 < ntiles) ? TILEPOS(1) : firstpos; kA = *(const u32x4*)(Kp + (size_t)(p1 + sr) * 64 + sc); vA = *(const u32x4*)(Vp + (size_t)p1 * 64 + vgo); }
    *(LAS u32x4*)(lds + stoff) = kB; *(LAS u32x4*)(lds + vst) = vB;
    __syncthreads();
#pragma unroll 1
    for (int i2 = 0; i2 < ntiles; i2 += 2) {
        {   const int i = i2; const int buf = i & 1, curpos = TILEPOS(i); const bool more = (i + 1) < ntiles;
            { const int pos2 = (i + 2 < ntiles) ? TILEPOS(i + 2) : curpos;
              kB = *(const u32x4*)(Kp + (size_t)(pos2 + sr) * 64 + sc); vB = *(const u32x4*)(Vp + (size_t)pos2 * 64 + vgo); }
        const LAS unsigned char* Kt = lds + buf * ABUF_BYTES; const LAS unsigned char* Vt = Kt + 9216;
        float mf[2][NB]; f32x4 s[2][NB][4];
#pragma unroll
        for (int qg = 0; qg < 2; ++qg)
#pragma unroll
            for (int br = 0; br < NB; ++br) mf[qg][br] = (m[qg][br] < -1e29f) ? 0.f : m[qg][br];
        bf16x8 kfr[8];
#pragma unroll
        for (int g = 0; g < 4; ++g) { kfr[2 * g] = *(const LAS bf16x8*)(Kt + ((16 * g + fr) * KSTR + fq * 8) * 2); kfr[2 * g + 1] = *(const LAS bf16x8*)(Kt + ((16 * g + fr) * KSTR + 32 + fq * 8) * 2); }
        __builtin_amdgcn_sched_barrier(0);
#pragma unroll
        for (int g = 0; g < 4; ++g) {
            const bf16x8 k0 = kfr[2 * g], k1 = kfr[2 * g + 1];
#pragma unroll
            for (int qg = 0; qg < 2; ++qg) {
                const float c0 = -mf[qg][0];
                if (DIFF) { const float c1 = -mf[qg][NB - 1];
                    s[qg][0][g] = MFMA16(k0, qf[qg][0], ((f32x4){c0, c0, c0, c0})); s[qg][NB - 1][g] = MFMA16(k1, qf[qg][1], ((f32x4){c1, c1, c1, c1})); }
                else { s[qg][0][g] = MFMA16(k0, qf[qg][0], ((f32x4){c0, c0, c0, c0})); s[qg][0][g] = MFMA16(k1, qf[qg][1], s[qg][0][g]); }
            }
        }
        if (!DIFF && maskmode != 0 && i >= nfirst) {
            if (maskmode == 1) {
#pragma unroll
                for (int qg = 0; qg < 2; ++qg)
#pragma unroll
                    for (int g = 0; g < 4; ++g)
#pragma unroll
                        for (int j = 0; j < 4; ++j) { const int d = curpos + 16 * g + 4 * fq + j - (qbase + 16 * qg); s[qg][0][g][j] = (d <= 128 && d >= -128) ? s[qg][0][g][j] : -1e30f; }
            } else {
                const int kr = curpos >> 6;
#pragma unroll
                for (int qg = 0; qg < 2; ++qg) {
                    const int qrow = qbase + 16 * qg, r = qrow >> 6, c = qrow & 63;
                    const int rs = min(max(r - 4, 0), 24), cs = min(max(c - 8, 0), 48);
                    const bool rowok = (kr >= rs) && (kr < rs + 8);
                    const volatile LAS float* bb = bias + ((kr - r + 7) * 31 - c + 15 + 4 * fq);
                    float bv[4][4];
#pragma unroll
                    for (int g = 0; g < 4; ++g)
#pragma unroll
                        for (int j = 0; j < 4; ++j) bv[g][j] = bb[16 * g + j];
                    const int lo = cs - 4 * fq, hi = cs + 16 - 4 * fq;
#pragma unroll
                    for (int g = 0; g < 4; ++g)
#pragma unroll
                        for (int j = 0; j < 4; ++j) { const bool ok = rowok && (16 * g + j >= lo) && (16 * g + j < hi);
                            s[qg][0][g][j] = ok ? s[qg][0][g][j] + bv[g][j] : -1e30f; }
                }
            }
        }
        bf16x8 p[2][NB][2];
#pragma unroll
        for (int qg = 0; qg < 2; ++qg)
#pragma unroll
            for (int br = 0; br < NB; ++br) {
                f32x4 (&t)[4] = s[qg][br];
                int im = max(max(max(__builtin_bit_cast(int, t[0][0]), __builtin_bit_cast(int, t[0][1])), max(__builtin_bit_cast(int, t[0][2]), __builtin_bit_cast(int, t[0][3]))),
                             max(max(__builtin_bit_cast(int, t[1][0]), __builtin_bit_cast(int, t[1][1])), max(__builtin_bit_cast(int, t[1][2]), __builtin_bit_cast(int, t[1][3]))));
                im = max(im, max(max(max(__builtin_bit_cast(int, t[2][0]), __builtin_bit_cast(int, t[2][1])), max(__builtin_bit_cast(int, t[2][2]), __builtin_bit_cast(int, t[2][3]))),
                                 max(max(__builtin_bit_cast(int, t[3][0]), __builtin_bit_cast(int, t[3][1])), max(__builtin_bit_cast(int, t[3][2]), __builtin_bit_cast(int, t[3][3])))));
                if (__any(im > 0x41000000   || m[qg][br] < -1e29f)) {
                    float mx = fmaxf(fmaxf(fmaxf(t[0][0], t[0][1]), fmaxf(t[0][2], t[0][3])), fmaxf(fmaxf(t[1][0], t[1][1]), fmaxf(t[1][2], t[1][3])));
                    mx = fmaxf(mx, fmaxf(fmaxf(fmaxf(t[2][0], t[2][1]), fmaxf(t[2][2], t[2][3])), fmaxf(fmaxf(t[3][0], t[3][1]), fmaxf(t[3][2], t[3][3]))));
                    mx = fmaxf(mx, __shfl_xor(mx, 16)); mx = fmaxf(mx, __shfl_xor(mx, 32));
                    const float mabs = mx + mf[qg][br];
                    const float mn = fmaxf(m[qg][br], mabs), alpha = __builtin_amdgcn_exp2f(m[qg][br] - mn), shift = mn - mf[qg][br];
                    m[qg][br] = mn; l[qg][br] = l[qg][br] * alpha;
#pragma unroll
                    for (int g = 0; g < 4; ++g) t[g] = t[g] - shift;
#pragma unroll
                    for (int dg = 0; dg < 4; ++dg) o[qg][br][dg] = o[qg][br][dg] * alpha;
                }
#pragma unroll
                for (int g = 0; g < 4; ++g)
#pragma unroll
                    for (int j = 0; j < 4; ++j) t[g][j] = __builtin_amdgcn_exp2f(t[g][j]);
                u32x4 p0u, p1u;
                p0u.x = pk2v(t[0][0], t[0][1]); p0u.y = pk2v(t[0][2], t[0][3]); p0u.z = pk2v(t[1][0], t[1][1]); p0u.w = pk2v(t[1][2], t[1][3]);
                p1u.x = pk2v(t[2][0], t[2][1]); p1u.y = pk2v(t[2][2], t[2][3]); p1u.z = pk2v(t[3][0], t[3][1]); p1u.w = pk2v(t[3][2], t[3][3]);
                p[qg][br][0] = __builtin_bit_cast(bf16x8, p0u); p[qg][br][1] = __builtin_bit_cast(bf16x8, p1u);
                l[qg][br] = MFMA16(ones, p[qg][br][0], l[qg][br]); l[qg][br] = MFMA16(ones, p[qg][br][1], l[qg][br]);
            }
        u32x2 vfr[4][4];
#pragma unroll
        for (int dg = 0; dg < 4; ++dg) { const LAS unsigned char* vrow = Vt + ((16 * dg + fr) * KSTR + 4 * fq) * 2;
            vfr[dg][0] = *(const LAS u32x2*)(vrow); vfr[dg][1] = *(const LAS u32x2*)(vrow + 32); vfr[dg][2] = *(const LAS u32x2*)(vrow + 64); vfr[dg][3] = *(const LAS u32x2*)(vrow + 96); }
        __builtin_amdgcn_sched_barrier(0);
#pragma unroll
        for (int dg = 0; dg < 4; ++dg) {
            const u32x2 a = vfr[dg][0], b = vfr[dg][1], cc = vfr[dg][2], d = vfr[dg][3];
            u32x4 v0; v0.x = a.x; v0.y = a.y; v0.z = b.x; v0.w = b.y;
            u32x4 v1; v1.x = cc.x; v1.y = cc.y; v1.z = d.x; v1.w = d.y;
            const bf16x8 va0 = __builtin_bit_cast(bf16x8, v0), va1 = __builtin_bit_cast(bf16x8, v1);
#pragma unroll
            for (int qg = 0; qg < 2; ++qg)
#pragma unroll
                for (int br = 0; br < NB; ++br) { o[qg][br][dg] = MFMA16(va0, p[qg][br][0], o[qg][br][dg]); o[qg][br][dg] = MFMA16(va1, p[qg][br][1], o[qg][br][dg]); }
        }
        if (more) { *(LAS u32x4*)(lds + (buf ^ 1) * ABUF_BYTES + stoff) = kA; *(LAS u32x4*)(lds + (buf ^ 1) * ABUF_BYTES + vst) = vA; }
        __syncthreads();
        }
        if (i2 + 1 >= ntiles) break;
        {   const int i = i2 + 1; const int buf = i & 1, curpos = TILEPOS(i); const bool more = (i + 1) < ntiles;
            { const int pos2 = (i + 2 < ntiles) ? TILEPOS(i + 2) : curpos;
              kA = *(const u32x4*)(Kp + (size_t)(pos2 + sr) * 64 + sc); vA = *(const u32x4*)(Vp + (size_t)pos2 * 64 + vgo); }
        const LAS unsigned char* Kt = lds + buf * ABUF_BYTES; const LAS unsigned char* Vt = Kt + 9216;
        float mf[2][NB]; f32x4 s[2][NB][4];
#pragma unroll
        for (int qg = 0; qg < 2; ++qg)
#pragma unroll
            for (int br = 0; br < NB; ++br) mf[qg][br] = (m[qg][br] < -1e29f) ? 0.f : m[qg][br];
        bf16x8 kfr[8];
#pragma unroll
        for (int g = 0; g < 4; ++g) { kfr[2 * g] = *(const LAS bf16x8*)(Kt + ((16 * g + fr) * KSTR + fq * 8) * 2); kfr[2 * g + 1] = *(const LAS bf16x8*)(Kt + ((16 * g + fr) * KSTR + 32 + fq * 8) * 2); }
        __builtin_amdgcn_sched_barrier(0);
#pragma unroll
        for (int g = 0; g < 4; ++g) {
            const bf16x8 k0 = kfr[2 * g], k1 = kfr[2 * g + 1];
#pragma unroll
            for (int qg = 0; qg < 2; ++qg) {
                const float c0 = -mf[qg][0];
                if (DIFF) { const float c1 = -mf[qg][NB - 1];
                    s[qg][0][g] = MFMA16(k0, qf[qg][0], ((f32x4){c0, c0, c0, c0})); s[qg][NB - 1][g] = MFMA16(k1, qf[qg][1], ((f32x4){c1, c1, c1, c1})); }
                else { s[qg][0][g] = MFMA16(k0, qf[qg][0], ((f32x4){c0, c0, c0, c0})); s[qg][0][g] = MFMA16(k1, qf[qg][1], s[qg][0][g]); }
            }
        }
        if (!DIFF && maskmode != 0 && i >= nfirst) {
            if (maskmode == 1) {
#pragma unroll
                for (int qg = 0; qg < 2; ++qg)
#pragma unroll
                    for (int g = 0; g < 4; ++g)
#pragma unroll
                        for (int j = 0; j < 4; ++j) { const int d = curpos + 16 * g + 4 * fq + j - (qbase + 16 * qg); s[qg][0][g][j] = (d <= 128 && d >= -128) ? s[qg][0][g][j] : -1e30f; }
            } else {
                const int kr = curpos >> 6;
#pragma unroll
                for (int qg = 0; qg < 2; ++qg) {
                    const int qrow = qbase + 16 * qg, r = qrow >> 6, c = qrow & 63;
                    const int rs = min(max(r - 4, 0), 24), cs = min(max(c - 8, 0), 48);
                    const bool rowok = (kr >= rs) && (kr < rs + 8);
                    const volatile LAS float* bb = bias + ((kr - r + 7) * 31 - c + 15 + 4 * fq);
                    float bv[4][4];
#pragma unroll
                    for (int g = 0; g < 4; ++g)
#pragma unroll
                        for (int j = 0; j < 4; ++j) bv[g][j] = bb[16 * g + j];
                    const int lo = cs - 4 * fq, hi = cs + 16 - 4 * fq;
#pragma unroll
                    for (int g = 0; g < 4; ++g)
#pragma unroll
                        for (int j = 0; j < 4; ++j) { const bool ok = rowok && (16 * g + j >= lo) && (16 * g + j < hi);
                            s[qg][0][g][j] = ok ? s[qg][0][g][j] + bv[g][j] : -1e30f; }
                }
            }
        }
        bf16x8 p[2][NB][2];
#pragma unroll
        for (int qg = 0; qg < 2; ++qg)
#pragma unroll
            for (int br = 0; br < NB; ++br) {
                f32x4 (&t)[4] = s[qg][br];
                int im = max(max(max(__builtin_bit_cast(int, t[0][0]), __builtin_bit_cast(int, t[0][1])), max(__builtin_bit_cast(int, t[0][2]), __builtin_bit_cast(int, t[0][3]))),
                             max(max(__builtin_bit_cast(int, t[1][0]), __builtin_bit_cast(int, t[1][1])), max(__builtin_bit_cast(int, t[1][2]), __builtin_bit_cast(int, t[1][3]))));
                im = max(im, max(max(max(__builtin_bit_cast(int, t[2][0]), __builtin_bit_cast(int, t[2][1])), max(__builtin_bit_cast(int, t[2][2]), __builtin_bit_cast(int, t[2][3]))),
                                 max(max(__builtin_bit_cast(int, t[3][0]), __builtin_bit_cast(int, t[3][1])), max(__builtin_bit_cast(int, t[3][2]), __builtin_bit_cast(int, t[3][3])))));
                if (__any(im > 0x41000000   || m[qg][br] < -1e29f)) {
                    float mx = fmaxf(fmaxf(fmaxf(t[0][0], t[0][1]), fmaxf(t[0][2], t[0][3])), fmaxf(fmaxf(t[1][0], t[1][1]), fmaxf(t[1][2], t[1][3])));
                    mx = fmaxf(mx, fmaxf(fmaxf(fmaxf(t[2][0], t[2][1]), fmaxf(t[2][2], t[2][3])), fmaxf(fmaxf(t[3][0], t[3][1]), fmaxf(t[3][2], t[3][3]))));
                    mx = fmaxf(mx, __shfl_xor(mx, 16)); mx = fmaxf(mx, __shfl_xor(mx, 32));
                    const float mabs = mx + mf[qg][br];
                    const float mn = fmaxf(m[qg][br], mabs), alpha = __builtin_amdgcn_exp2f(m[qg][br] - mn), shift = mn - mf[qg][br];
                    m[qg][br] = mn; l[qg][br] = l[qg][br] * alpha;
#pragma unroll
                    for (int g = 0; g < 4; ++g) t[g] = t[g] - shift;
#pragma unroll
                    for (int dg = 0; dg < 4; ++dg) o[qg][br][dg] = o[qg][br][dg] * alpha;
                }
#pragma unroll
                for (int g = 0; g < 4; ++g)
#pragma unroll
                    for (int j = 0; j < 4; ++j) t[g][j] = __builtin_amdgcn_exp2f(t[g][j]);
                u32x4 p0u, p1u;
                p0u.x = pk2v(t[0][0], t[0][1]); p0u.y = pk2v(t[0][2], t[0][3]); p0u.z = pk2v(t[1][0], t[1][1]); p0u.w = pk2v(t[1][2], t[1][3]);
                p1u.x = pk2v(t[2][0], t[2][1]); p1u.y = pk2v(t[2][2], t[2][3]); p1u.z = pk2v(t[3][0], t[3][1]); p1u.w = pk2v(t[3][2], t[3][3]);
                p[qg][br][0] = __builtin_bit_cast(bf16x8, p0u); p[qg][br][1] = __builtin_bit_cast(bf16x8, p1u);
                l[qg][br] = MFMA16(ones, p[qg][br][0], l[qg][br]); l[qg][br] = MFMA16(ones, p[qg][br][1], l[qg][br]);
            }
        u32x2 vfr[4][4];
#pragma unroll
        for (int dg = 0; dg < 4; ++dg) { const LAS unsigned char* vrow = Vt + ((16 * dg + fr) * KSTR + 4 * fq) * 2;
            vfr[dg][0] = *(const LAS u32x2*)(vrow); vfr[dg][1] = *(const LAS u32x2*)(vrow + 32); vfr[dg][2] = *(const LAS u32x2*)(vrow + 64); vfr[dg][3] = *(const LAS u32x2*)(vrow + 96); }
        __builtin_amdgcn_sched_barrier(0);
#pragma unroll
        for (int dg = 0; dg < 4; ++dg) {
            const u32x2 a = vfr[dg][0], b = vfr[dg][1], cc = vfr[dg][2], d = vfr[dg][3];
            u32x4 v0; v0.x = a.x; v0.y = a.y; v0.z = b.x; v0.w = b.y;
            u32x4 v1; v1.x = cc.x; v1.y = cc.y; v1.z = d.x; v1.w = d.y;
            const bf16x8 va0 = __builtin_bit_cast(bf16x8, v0), va1 = __builtin_bit_cast(bf16x8, v1);
#pragma unroll
            for (int qg = 0; qg < 2; ++qg)
#pragma unroll
                for (int br = 0; br < NB; ++br) { o[qg][br][dg] = MFMA16(va0, p[qg][br][0], o[qg][br][dg]); o[qg][br][dg] = MFMA16(va1, p[qg][br][1], o[qg][br][dg]); }
        }
        if (more) { *(LAS u32x4*)(lds + (buf ^ 1) * ABUF_BYTES + stoff) = kB; *(LAS u32x4*)(lds + (buf ^ 1) * ABUF_BYTES + vst) = vB; }
        __syncthreads();
        }
    }
#undef TILEPOS
#pragma unroll
    for (int qg = 0; qg < 2; ++qg) {
        const float inv1 = 1.0f / l[qg][0][0];
        bf16_t* yr = Yp + (size_t)(wave * 32 + qg * 16 + fr) * 1024 + 4 * fq;
        if (DIFF) {
            const float inv2 = lam / l[qg][NB - 1][0];
            f32x4 y[4]; float ss = 0.f;
#pragma unroll
            for (int dg = 0; dg < 4; ++dg) { y[dg] = o[qg][0][dg] * inv1 - o[qg][NB - 1][dg] * inv2; ss += (y[dg][0] * y[dg][0] + y[dg][1] * y[dg][1]) + (y[dg][2] * y[dg][2] + y[dg][3] * y[dg][3]); }
            ss += __shfl_xor(ss, 16); ss += __shfl_xor(ss, 32);
            const float rr = oscale / sqrtf(ss * (1.0f / 64.0f) + 1e-6f);
#pragma unroll
            for (int dg = 0; dg < 4; ++dg) { const f32x4 gv = *(const f32x4*)(subg + 16 * dg + 4 * fq); const f32x4 yy = y[dg] * rr * gv;
                *(unsigned long long*)(yr + 16 * dg) = (unsigned long long)pk2(yy[0], yy[1]) | ((unsigned long long)pk2(yy[2], yy[3]) << 32); }
        } else {
#pragma unroll
            for (int dg = 0; dg < 4; ++dg) { const f32x4 yy = o[qg][0][dg] * inv1;
                *(unsigned long long*)(yr + 16 * dg) = (unsigned long long)pk2(yy[0], yy[1]) | ((unsigned long long)pk2(yy[2], yy[3]) << 32); }
        }
    }
}

__device__ __forceinline__ void attn_phase(LAS unsigned char* lds, unsigned* counter, bool with_ctx, const bf16_t* Qb, const bf16_t* Kb, const bf16_t* Vtb, bf16_t* Y,
                                           const float* sink, const float* relb, const float* subg, float lam, float oscale, int tid, int lane, int wave) {
    const int nunits = with_ctx ? 1152 : 1024;
    LAS float* bias = (LAS float*)(lds + ATT_BIAS_OFF);
    LAS int* cur = (LAS int*)(lds + ATT_CUR_OFF);
    for (;;) {
        if (tid == 0) *cur = (int)atomicAdd(counter, 1u);
        __syncthreads();
        const int u = *cur;
        __syncthreads();
        if (u >= nunits) break;
        int mo, b, h, q0;
        if (u < 1024) { mo = u >> 8; const int i = u & 255; b = i >> 5; h = (i >> 3) & 3; q0 = (i & 7) * 256; }
        else { const int v = u - 1024; mo = v >> 5; const int i = v & 31; b = i >> 2; h = i & 3; q0 = 2048; }
        const int mixer = mo == 0 ? 3 : (mo == 1 ? 1 : (mo == 2 ? 2 : 0));
        const int kvh = (mixer < 2) ? (h >> 1) : h;
        const int kvbase = mixer == 0 ? 0 : (mixer == 1 ? 2 : (mixer == 2 ? 4 : 8));
        const bf16_t* Qp = Qb + (size_t)((mixer * 8 + b) * 4 + h) * POS * 64;
        const bf16_t* Kp = Kb + (size_t)((kvbase + kvh) * 8 + b) * POS * 64;
        const bf16_t* Vp = Vtb + (size_t)((kvbase + kvh) * 8 + b) * POS * 64;
        const bool isctx = q0 >= 2048;
        const int yrow0 = isctx ? ML + b * 256 : b * 2048 + q0;
        bf16_t* Yp = Y + (size_t)yrow0 * 1024 + mixer * 256 + h * 64;
        int ntiles, nfirst, firstpos, secondpos = 0, maskmode = 0;
        if (isctx) { ntiles = 4; nfirst = 4; firstpos = 2048; }
        else if (mixer == 1 || mixer == 3) { ntiles = 36; nfirst = 36; firstpos = 0; }
        else if (mixer == 0) { const int lo = max(0, q0 - 128), hi = min(2048, q0 + 384); nfirst = 4; firstpos = 2048; secondpos = lo; ntiles = 4 + (hi - lo) / 64; maskmode = 1; }
        else { const int r0 = q0 >> 6; const int rs0 = min(max(r0 - 4, 0), 24), rs3 = min(max(r0 - 1, 0), 24); nfirst = 4; firstpos = 2048; secondpos = rs0 * 64; ntiles = 4 + (rs3 + 8 - rs0); maskmode = 2;
            for (int i = tid; i < 465; i += NT) bias[i] = relb[h * 465 + i] * LOG2E; }
        float m_init = -1e30f; bool sinkf = false;
        if (mixer == 0) { m_init = sink[h] * LOG2E; sinkf = true; }
        if (mixer == 3) attn_unit<true>(lds, Qp, Kp, Vp, Yp, q0, ntiles, nfirst, firstpos, secondpos, 0, -1e30f, false, bias, lam, subg, oscale, wave);
        else attn_unit<false>(lds, Qp, Kp, Vp, Yp, q0, ntiles, nfirst, firstpos, secondpos, maskmode, m_init, sinkf, bias, 0.f, subg, 1.f, wave);
    }
}

struct Args { const float* in[24]; float* out; unsigned char* ws; };
#define CAS __attribute__((address_space(4)))
__device__ __forceinline__ const CAS char* kargs() { const CAS char* p = (const CAS char*)__builtin_amdgcn_kernarg_segment_ptr(); asm volatile("" : "+s"(p)); return p; }
__device__ __forceinline__ const float* ldin(int i) { return *(const float* const CAS*)(kargs() + 8 * i); }
__device__ __forceinline__ float* ldout() { return *(float* const CAS*)(kargs() + 192); }
__device__ __forceinline__ unsigned char* ldws() { return *(unsigned char* const CAS*)(kargs() + 200); }
__global__ void __launch_bounds__(NT, 2) fwd_kernel(Args a) {
    extern __shared__ __attribute__((aligned(16))) unsigned char lds_raw[];
    LAS unsigned char* lds = (LAS unsigned char*)lds_raw;
    cg::grid_group grid = cg::this_grid();
#define TID (tid_now())
#define LANE (TID & 63)
#define WAVE (__builtin_amdgcn_readfirstlane(TID >> 6))
#define GRD (grd_now())
#define BID (bid_now())
#define GW (BID * 8 + WAVE)
#define NGW (GRD * 8)
#define WSF(off) ((float*)(ldws() + (off)))
#define WSB(off) ((bf16_t*)(ldws() + (off)))

    if (grd_now() == 0x7fffffff) grid.sync();
    if (tid_now() < 16) ((LAS unsigned*)(lds + MISC_OFF))[tid_now()] = 0u;
    __syncthreads();
    (void)xcd_barrier_post((unsigned*)(ldws() + WS_BAR), (volatile LAS unsigned*)(lds + MISC_OFF));
    if (BID == GRD - 1) p0_misc(WSF(WS_ROPE), WSF(WS_SCAL), ldin(15), ldin(16), ldin(17), ldin(18), TID);
#pragma unroll 1
    for (int rep = 0; rep < REP_LIGHT; ++rep)
    p0_mod(lds, ldin(1), ldin(3), ldin(4), ldin(5), WSF(WS_MOD), BID, GRD, TID);
    GSYNC();

#define FUSE (GRD == 256)
#define MODL(ll) (WSF(WS_MOD) + (size_t)(ll) * 9 * 9216)
#define CNT(inst) ((unsigned*)(ldws() + WS_CNT) + (inst) * 64 * 16)
#pragma unroll 1
    for (int it = 0; it < 4; ++it) {
        const int l = it >> 1, f = it & 1;
        const bool lat_only = (l == 1 && f == 1);
        if (f == 0) convert_layer(lds, l, ldin(6), ldin(7), ldin(8), ldin(9), ldin(10), ldin(20), ldin(21), ldin(22), ldws() + WS_W, GW, NGW, WAVE, LANE);
        if (it == 0) norm_mod_phase(ldin(0), ldin(2), nullptr, nullptr, nullptr, WSF(WS_XC), WSB(WS_H), MODL(0), 0, 0, MT, GW, NGW, LANE);
        else if (!FUSE) norm_mod_phase(ldout(), WSF(WS_XC), nullptr, nullptr, (it == 1 || it == 2) ? SPLIT_PART : nullptr, WSF(WS_XC), WSB(WS_H), MODL(l), f ? 6 : 0, 0, lat_only ? ML : MT, GW, NGW, LANE);
        else if (!lat_only) norm_mod_phase(ldout(), WSF(WS_XC), nullptr, nullptr, SPLIT_PART, WSF(WS_XC), WSB(WS_H), MODL(l), f ? 6 : 0, ML, MT, GW, NGW, LANE);
        if (!(FUSE && lat_only)) GSYNC();
        {
            const int M = lat_only ? ML : MT;
            pg8::Gemm g{WSB(WS_H), (const bf16_t*)(ldws() + WS_W + (f ? W_GU2 : W_GU1)), M, 2 * DFF, DM}; pg8::StaticOrder S; S.init(M, 2 * DFF, GRD, BID, DM);
            pg8::EpiSwiglu E{WSB(WS_G), DFF};
            pg8::gemm_phase<pg8::EpiSwiglu, pg8::StaticOrder, true, true>(lds, g, S, E);
        }
        GSYNC();
        {
            const int M = lat_only ? ML : MT;
            pg8::Gemm g{WSB(WS_G), (const bf16_t*)(ldws() + WS_W + (f ? W_D2 : W_D1)), M, DM, DFF}; pg8::SplitOrder S; S.init(M, DM, GRD, BID, DFF);
            const float* nsh = (f == 0) ? MODL(l) + 3 * 1024 : ((it == 1) ? MODL(1) : ldin(23));
            pg8::EpiRes E{ldout(), WSF(WS_XC), MODL(l) + (f ? 8 : 2) * 1024, 0.5f, DFF / 64, WSF(WS_Q), (it == 0) ? ldin(0) : (const float*)ldout(), (it == 0) ? ldin(2) : (const float*)WSF(WS_XC), FUSE ? 1 : 0, (it == 3) ? 1 : 0, WSB(WS_H), nsh, WSF(WS_SLOTS), CNT(it)};
            pg8::gemm_phase<pg8::EpiRes, pg8::SplitOrder, true, true>(lds, g, S, E);
        }
        if (it < 3) GSYNC();
        if (f == 0) {
            if (!FUSE) norm_mod_phase(ldout(), (it == 0 && SPLIT_PART) ? ldin(2) : (const float*)WSF(WS_XC), nullptr, nullptr, SPLIT_PART, WSF(WS_XC), WSB(WS_H), MODL(l), 3, 0, MT, GW, NGW, LANE);
            else norm_mod_phase(ldout(), (it == 0) ? ldin(2) : (const float*)WSF(WS_XC), nullptr, nullptr, SPLIT_PART, WSF(WS_XC), WSB(WS_H), MODL(l), 3, ML, MT, GW, NGW, LANE);
            GSYNC();
            {
                pg8::Gemm g{WSB(WS_H), (const bf16_t*)(ldws() + WS_W + W_IN), MT, INW, DM}; pg8::StaticOrder S; S.init(MT, INW, GRD, BID, DM);
                pg8::EpiQKV E{WSB(WS_Q), WSB(WS_K), WSB(WS_VT), WSF(WS_ROPE), ldin(12) + l * 64, ldin(13) + l * 64, lds + 131072};
#pragma unroll 1
                for (int rep = 0; rep < REP_GU; ++rep)
                pg8::gemm_phase<pg8::EpiQKV, pg8::StaticOrder, true, true>(lds, g, S, E);
            }
            GSYNC();
            {
                const float lam = __hip_atomic_load(WSF(WS_SCAL) + l, __ATOMIC_RELAXED, __HIP_MEMORY_SCOPE_AGENT); const float lam_init = 0.8f - 0.6f * expf(-0.3f * (float)l);
#pragma unroll 1
                for (int rep = 0; rep < REP_ATT; ++rep)
                attn_phase(lds, (unsigned*)(ldws() + WS_CTL) + 64 * l + 16 * rep, l == 0, WSB(WS_Q), WSB(WS_K), WSB(WS_VT), WSB(WS_H), ldin(11) + l * 4, ldin(14) + l * 4 * 465, ldin(19) + l * 64, lam, 1.0f - lam_init, TID, LANE, WAVE);
            }
            GSYNC();
            {
                const int M = (l == 1) ? ML : MT;
                pg8::Gemm g{WSB(WS_H), (const bf16_t*)(ldws() + WS_W + W_OUT), M, DM, DM}; pg8::SplitOrder S; S.init(M, DM, GRD, BID, DM);
                pg8::EpiRes E{ldout(), WSF(WS_XC), MODL(l) + 5 * 1024, 1.0f, DM / 64, WSF(WS_Q), (const float*)ldout(), (const float*)WSF(WS_XC), FUSE ? 1 : 0, 0, WSB(WS_H), MODL(l) + 6 * 1024, WSF(WS_SLOTS), CNT(4 + l)};
                pg8::gemm_phase<pg8::EpiRes, pg8::SplitOrder, true, true>(lds, g, S, E);
            }
            GSYNC();
        }
    }
    if (!FUSE) { GSYNC(); final_norm_phase(ldout(), ldin(23), GW, NGW, LANE); }

}

extern "C" void kernel_launch(void* const* d_in, const int* in_sizes, int n_in, void* d_out, int out_size, void* d_ws, size_t ws_size, hipStream_t stream) {
    static int grid = 0;
    if (grid == 0) {
        if (n_in != 24 || out_size != ML * DM || ws_size < WS_END) { fprintf(stderr, "kernel_launch: unexpected shapes (n_in %d out %d ws %zu)\n", n_in, out_size, ws_size); grid = -1; return; }
        int dev = 0, cus = 0, per_cu = 0;
        (void)hipGetDevice(&dev);
        (void)hipDeviceGetAttribute(&cus, hipDeviceAttributeMultiprocessorCount, dev);
        (void)hipFuncSetAttribute((const void*)fwd_kernel, hipFuncAttributeMaxDynamicSharedMemorySize, LDS_BYTES);
        if (hipOccupancyMaxActiveBlocksPerMultiprocessor(&per_cu, (const void*)fwd_kernel, NT, LDS_BYTES) != hipSuccess || per_cu < 1) per_cu = 1;
        (void)hipGetLastError();
        grid = cus * 1;
    }
    if (grid < 0) return;
    (void)hipMemsetAsync((char*)d_ws + WS_CTL, 0, CTL_ZERO_BYTES, stream);
    Args a{};
    for (int i = 0; i < 24; ++i) a.in[i] = (const float*)d_in[i];
    a.out = (float*)d_out; a.ws = (unsigned char*)d_ws;
    void* args[] = {&a};
    hipError_t e = hipLaunchCooperativeKernel((const void*)fwd_kernel, dim3(grid), dim3(NT), args, LDS_BYTES, stream);
    if (e != hipSuccess) fprintf(stderr, "cooperative launch failed: %s (grid %d)\n", hipGetErrorString(e), grid);
}
```

```cpp
#include <hip/hip_runtime.h>
#include <hip/hip_cooperative_groups.h>
#include <cstdio>
#include <cstdint>
namespace cg = cooperative_groups;
__device__ __forceinline__ int tid_now() { int t = (int)threadIdx.x; asm volatile("" : "+v"(t)); return t; }
__device__ __forceinline__ int bid_now() { int t = (int)blockIdx.x; asm volatile("" : "+s"(t)); return t; }
__device__ __forceinline__ int grd_now() { int t = (int)gridDim.x; asm volatile("" : "+s"(t)); return t; }
namespace pg8 {
#define PG8_LAS __attribute__((address_space(3)))
typedef unsigned short bf16_t;
typedef short bf16x8 __attribute__((ext_vector_type(8)));
typedef float f32x4 __attribute__((ext_vector_type(4)));
typedef unsigned u32x4 __attribute__((ext_vector_type(4)));
constexpr int BM = 256, BK = 64, HALF = 128, HTB = HALF * BK * 2  , STAGE_BYTES = 8 * HTB, NXCD = 8, WGM = 8;

__host__ __device__ __forceinline__ int lds_byte(int r, int c) { const int st = (r >> 4) * 2 + (c >> 5), rr = r & 15, cc = c & 31, ob = rr * 64 + cc * 2; return st * 1024 + (ob ^ (((ob >> 9) & 1) << 5)); }
__host__ __device__ __forceinline__ void stage_rc(int b, int& R, int& C) { const int st = b / 1024, sb = b % 1024, swz = sb ^ (((sb >> 9) & 1) << 5); R = (st >> 1) * 16 + swz / 64; C = (st & 1) * 32 + (swz % 64) / 2; }
__host__ __device__ __forceinline__ int perm32(int rho) { const int n = rho >> 4, i = rho & 15; return 8 * (i >> 2) + 4 * n + (i & 3); }

struct Unit { int pm, pn, k0, nk, pt; };
struct Gemm { const bf16_t* A; const bf16_t* Bt; int M, N, K; };

struct StaticOrder {
    int nM, nN, nwg, G, c, nK;
    __host__ __device__ void init(int M, int N, int G_, int c_, int K_) { nM = M / BM; nN = N / BM; nwg = nM * nN; G = G_; c = c_; nK = K_ / BK; }
    __host__ __device__ bool next(int i, Unit& u) const {
        const long L = (long)i * G + c; if (L >= nwg) return false;
        int wgid = (int)L; { const int q = nwg / NXCD, r = nwg % NXCD, xcd = wgid % NXCD, off = wgid / NXCD; wgid = (xcd < r ? xcd * (q + 1) : r * (q + 1) + (xcd - r) * q) + off; }
        const int nig = WGM * nN, gid = wgid / nig, fm = gid * WGM, gsz = (nM - fm) < WGM ? (nM - fm) : WGM;
        u.pm = fm + ((wgid % nig) % gsz); u.pn = (wgid % nig) / gsz; u.k0 = 0; u.nk = nK; u.pt = 0; return true;
    }
    __device__ __forceinline__ void a_ready(const Unit&) const {}
    __device__ __forceinline__ void done(const Unit&) const {}
};
typedef __bf16 bf16x2c_t __attribute__((ext_vector_type(2)));
typedef float f32x2c_t __attribute__((ext_vector_type(2)));
__device__ __forceinline__ unsigned cvt_pk_bf16(float lo, float hi) { f32x2c_t v = {lo, hi}; bf16x2c_t r = __builtin_convertvector(v, bf16x2c_t); return __builtin_bit_cast(unsigned, r); }
typedef float f32x2 __attribute__((ext_vector_type(2)));
template <class Epi, class Sched, bool ALIGN_EPI = false, bool SP2 = false>
__device__ __forceinline__ void gemm_phase(PG8_LAS unsigned char* lds, const Gemm g, const Sched& S, const Epi& E) {
    const int tid = tid_now(), wid = __builtin_amdgcn_readfirstlane(tid >> 6), lane = tid & 63, wr = wid >> 2, wc = wid & 3, fr = lane & 15, fq = lane >> 4;
    const int K = g.K;
    unsigned voffA[2], voffB[2];
#pragma unroll
    for (int i = 0; i < 2; ++i) { int R, C; stage_rc(tid * 16 + i * 8192, R, C); const int Rb = Epi::PERM ? ((R & ~31) + perm32(R & 31)) : R;
        voffA[i] = (unsigned)(R * K + C) * 2u; voffB[i] = (unsigned)(Rb * K + C) * 2u; }
    const size_t kstep = (size_t)(BK * 2);
    const size_t hstep = (size_t)HALF * K * 2;
    const size_t tstep = 2 * hstep;
    const unsigned ldsw = (unsigned)wid * 1024u;
    const int aoff = lds_byte(wr * 64 + fr, fq * 8), boff = lds_byte(wc * 32 + fr, fq * 8);
#define PG8_SA(b, h) (((b) * 2 + (h)) * HTB)
#define PG8_SB(b, h) ((4 + (b) * 2 + (h)) * HTB)
#define PG8_STAGE(bufoff, gbase, voff) do { _Pragma("unroll") for (int _i = 0; _i < 2; ++_i) \
        __builtin_amdgcn_global_load_lds((const unsigned*)((const char*)(gbase) + (voff)[_i]), (PG8_LAS unsigned*)(lds + (bufoff) + ldsw + _i * 8192), 16, 0, 0); } while (0)
#define PG8_LDA(dst, b, h) do { _Pragma("unroll") for (int m = 0; m < 4; ++m) _Pragma("unroll") for (int k = 0; k < 2; ++k) dst[m][k] = *(const PG8_LAS bf16x8*)(lds + PG8_SA(b, h) + aoff + m * 2048 + k * 1024); } while (0)
#define PG8_LDB(dst, b, h) do { _Pragma("unroll") for (int n = 0; n < 2; ++n) _Pragma("unroll") for (int k = 0; k < 2; ++k) dst[n][k] = *(const PG8_LAS bf16x8*)(lds + PG8_SB(b, h) + boff + n * 2048 + k * 1024); } while (0)
#define PG8_MMA(ai, bj, At, Bt) do { __builtin_amdgcn_s_setprio(1); _Pragma("unroll") for (int m = 0; m < 4; ++m) _Pragma("unroll") for (int n = 0; n < 2; ++n) _Pragma("unroll") for (int k = 0; k < 2; ++k) \
        acc[ai][bj][m][n] = __builtin_amdgcn_mfma_f32_16x16x32_bf16(Bt[n][k], At[m][k], acc[ai][bj][m][n], 0, 0, 0); __builtin_amdgcn_s_setprio(0); } while (0)
#define PG8_WAIT_V(n) asm volatile("s_waitcnt vmcnt(" #n ")" ::: "memory")
#define PG8_WAIT_L(n) asm volatile("s_waitcnt lgkmcnt(" #n ")" ::: "memory")
#define PG8_BAR __builtin_amdgcn_s_barrier()
#define PG8_SCHED __builtin_amdgcn_sched_barrier(0)
    Unit cur, nxt; int ui = 0;
    if (!S.next(0, cur)) return;
    f32x4 acc[2][2][4][2];
#pragma unroll
    for (int a = 0; a < 2; ++a)
#pragma unroll
        for (int b = 0; b < 2; ++b)
#pragma unroll
            for (int m = 0; m < 4; ++m)
#pragma unroll
                for (int n = 0; n < 2; ++n) acc[a][b][m][n] = (f32x4){0.f, 0.f, 0.f, 0.f};
    bf16x8 At[4][2], B0[2][2], B1[2][2];
    const char* cA = (const char*)g.A + (size_t)cur.pm * tstep + (size_t)cur.k0 * kstep; const char* cB = (const char*)g.Bt + (size_t)cur.pn * tstep + (size_t)cur.k0 * kstep;
    S.a_ready(cur);
    if constexpr (SP2) {
        PG8_STAGE(PG8_SB(0, 0), cB, voffB); PG8_STAGE(PG8_SB(0, 1), cB + hstep, voffB); PG8_STAGE(PG8_SA(0, 0), cA, voffA); PG8_STAGE(PG8_SA(0, 1), cA + hstep, voffA);
        if (wr == 1) PG8_BAR;
        PG8_WAIT_V(2); PG8_BAR;
        PG8_STAGE(PG8_SB(1, 0), cB + kstep, voffB); PG8_STAGE(PG8_SA(1, 0), cA + kstep, voffA); PG8_STAGE(PG8_SB(1, 1), cB + hstep + kstep, voffB);
        PG8_WAIT_V(6); PG8_BAR;
    } else {
        PG8_STAGE(PG8_SB(0, 0), cB, voffB); PG8_STAGE(PG8_SA(0, 0), cA, voffA); PG8_STAGE(PG8_SB(0, 1), cB + hstep, voffB); PG8_STAGE(PG8_SA(0, 1), cA + hstep, voffA);
        if (wr == 1) PG8_BAR;
        PG8_WAIT_V(4); PG8_BAR;
        PG8_STAGE(PG8_SB(1, 0), cB + kstep, voffB); PG8_STAGE(PG8_SA(1, 0), cA + kstep, voffA); PG8_STAGE(PG8_SB(1, 1), cB + hstep + kstep, voffB);
        PG8_WAIT_V(6); PG8_BAR;
    }
    for (;;) {
        const bool has_next = S.next(ui + 1, nxt);
        const char* nA = has_next ? (const char*)g.A + (size_t)nxt.pm * tstep + (size_t)nxt.k0 * kstep : cA; const char* nB = has_next ? (const char*)g.Bt + (size_t)nxt.pn * tstep + (size_t)nxt.k0 * kstep : cB;
        const int nt = cur.nk;
        for (int t = 0; t < nt; t += 2) {
            const bool last = (t == nt - 2);
            const char* a1 = cA + (size_t)(t + 1) * kstep;
            const char* a2 = last ? nA : cA + (size_t)(t + 2) * kstep; const char* b2 = last ? nB : cB + (size_t)(t + 2) * kstep;
            const char* a3 = a2 + kstep; const char* b3 = b2 + kstep;
            if (last && has_next) S.a_ready(nxt);
            if constexpr (SP2) {
            PG8_LDB(B0, 0, 0); PG8_LDB(B1, 0, 1); PG8_SCHED; PG8_LDA(At, 0, 0); PG8_STAGE(PG8_SA(1, 1), a1 + hstep, voffA);
            PG8_WAIT_V(8); PG8_WAIT_L(0); PG8_BAR; PG8_MMA(0, 0, At, B0); PG8_MMA(0, 1, At, B1); PG8_BAR; PG8_SCHED;
            PG8_LDA(At, 0, 1); PG8_STAGE(PG8_SB(0, 0), b2, voffB); PG8_STAGE(PG8_SB(0, 1), b2 + hstep, voffB); PG8_STAGE(PG8_SA(0, 0), a2, voffA);
            PG8_WAIT_V(8); PG8_WAIT_L(0); PG8_BAR; PG8_MMA(1, 0, At, B0); PG8_MMA(1, 1, At, B1); PG8_BAR; PG8_SCHED;
            PG8_LDB(B0, 1, 0); PG8_LDB(B1, 1, 1); PG8_SCHED; PG8_LDA(At, 1, 0); PG8_STAGE(PG8_SA(0, 1), a2 + hstep, voffA);
            PG8_WAIT_V(8); PG8_WAIT_L(0); PG8_BAR; PG8_MMA(0, 0, At, B0); PG8_MMA(0, 1, At, B1); PG8_BAR; PG8_SCHED;
            PG8_LDA(At, 1, 1); PG8_STAGE(PG8_SB(1, 0), b3, voffB); PG8_STAGE(PG8_SB(1, 1), b3 + hstep, voffB); PG8_STAGE(PG8_SA(1, 0), a3, voffA);
            PG8_WAIT_V(8); PG8_WAIT_L(0); PG8_BAR; PG8_MMA(1, 0, At, B0); PG8_MMA(1, 1, At, B1); PG8_BAR; PG8_SCHED;
            } else {
            PG8_LDB(B0, 0, 0); PG8_SCHED; PG8_LDA(At, 0, 0); PG8_STAGE(PG8_SA(1, 1), a1 + hstep, voffA);
            PG8_WAIT_L(8); PG8_BAR; PG8_WAIT_L(0); PG8_MMA(0, 0, At, B0); PG8_BAR; PG8_SCHED;
            PG8_LDB(B1, 0, 1); PG8_STAGE(PG8_SB(0, 0), b2, voffB);
            PG8_BAR; PG8_WAIT_L(0); PG8_MMA(0, 1, At, B1); PG8_BAR;
            PG8_LDA(At, 0, 1); PG8_STAGE(PG8_SA(0, 0), a2, voffA);
            PG8_BAR; PG8_WAIT_L(0); PG8_MMA(1, 0, At, B0); PG8_BAR; PG8_SCHED;
            PG8_STAGE(PG8_SB(0, 1), b2 + hstep, voffB);
            PG8_WAIT_V(6); PG8_BAR; PG8_MMA(1, 1, At, B1); PG8_BAR;
            PG8_LDB(B0, 1, 0); PG8_SCHED; PG8_LDA(At, 1, 0); PG8_STAGE(PG8_SA(0, 1), a2 + hstep, voffA);
            PG8_WAIT_L(8); PG8_BAR; PG8_WAIT_L(0); PG8_MMA(0, 0, At, B0); PG8_BAR; PG8_SCHED;
            PG8_LDB(B1, 1, 1); PG8_STAGE(PG8_SB(1, 0), b3, voffB);
            PG8_BAR; PG8_WAIT_L(0); PG8_MMA(0, 1, At, B1); PG8_BAR;
            PG8_LDA(At, 1, 1); PG8_STAGE(PG8_SA(1, 0), a3, voffA);
            PG8_BAR; PG8_WAIT_L(0); PG8_MMA(1, 0, At, B0); PG8_BAR; PG8_SCHED;
            PG8_STAGE(PG8_SB(1, 1), b3 + hstep, voffB);
            PG8_WAIT_V(6); PG8_BAR; PG8_MMA(1, 1, At, B1); PG8_BAR;
            }
        }
        if constexpr (ALIGN_EPI) { if (wr == 0) PG8_BAR; }
        if constexpr (!Epi::AFTER_DRAIN) { E(acc, cur, wr, wc, fr, fq); S.done(cur); }
        else { if (has_next) E(acc, cur, wr, wc, fr, fq); }
        if (!has_next) break;
#pragma unroll
        for (int a = 0; a < 2; ++a)
#pragma unroll
            for (int b = 0; b < 2; ++b)
#pragma unroll
                for (int m = 0; m < 4; ++m)
#pragma unroll
                    for (int n = 0; n < 2; ++n) acc[a][b][m][n] = (f32x4){0.f, 0.f, 0.f, 0.f};
        cur = nxt; cA = nA; cB = nB; ++ui;
        if constexpr (ALIGN_EPI) { if (wr == 1) PG8_BAR; }
    }
    PG8_WAIT_V(0);
    if constexpr (!ALIGN_EPI) { if (wr == 0) PG8_BAR; }
    PG8_BAR;
    if constexpr (Epi::AFTER_DRAIN) { E.fused(acc, cur, wr, wc, fr, fq, lds, wid, lane); S.done(cur); }
#undef PG8_SA
#undef PG8_SB
#undef PG8_STAGE
#undef PG8_LDA
#undef PG8_LDB
#undef PG8_MMA
#undef PG8_WAIT_V
#undef PG8_WAIT_L
#undef PG8_BAR
#undef PG8_SCHED
}
}

namespace pg8 {
__device__ __forceinline__ float silu_f(float x) { return x * __builtin_amdgcn_rcpf(1.0f + __builtin_amdgcn_exp2f(-1.44269504f * x)); }

struct EpiPlain {
    static constexpr bool PERM = true, AFTER_DRAIN = false;
    bf16_t* O; int ldc;
    __device__ __forceinline__ void operator()(const f32x4 (&acc)[2][2][4][2], const Unit& u, int wr, int wc, int fr, int fq) const {
        const int row0 = u.pm * BM + wr * 64 + fr, col0 = u.pn * BM + wc * 32 + 8 * fq;
#pragma unroll
        for (int ai = 0; ai < 2; ++ai)
#pragma unroll
            for (int m = 0; m < 4; ++m) { bf16_t* rowp = O + (size_t)(row0 + ai * HALF + m * 16) * ldc + col0;
#pragma unroll
                for (int bj = 0; bj < 2; ++bj) { const f32x4 v0 = acc[ai][bj][m][0], v1 = acc[ai][bj][m][1]; u32x4 w;
                    w.x = cvt_pk_bf16(v0[0], v0[1]); w.y = cvt_pk_bf16(v0[2], v0[3]); w.z = cvt_pk_bf16(v1[0], v1[1]); w.w = cvt_pk_bf16(v1[2], v1[3]);
                    *(u32x4*)(rowp + bj * HALF) = w; } }
    }
};
struct EpiSwiglu {
    static constexpr bool PERM = true, AFTER_DRAIN = false;
    bf16_t* O; int ldc;
    __device__ __forceinline__ void operator()(const f32x4 (&acc)[2][2][4][2], const Unit& u, int wr, int wc, int fr, int fq) const {
        const int row0 = u.pm * BM + wr * 64 + fr, col0 = u.pn * HALF + wc * 32 + 8 * fq;
#pragma unroll
        for (int ai = 0; ai < 2; ++ai)
#pragma unroll
            for (int m = 0; m < 4; ++m) { bf16_t* rowp = O + (size_t)(row0 + ai * HALF + m * 16) * ldc + col0;
                const f32x4 g0 = acc[ai][0][m][0], g1 = acc[ai][0][m][1], u0 = acc[ai][1][m][0], u1 = acc[ai][1][m][1]; u32x4 w;
                w.x = cvt_pk_bf16(silu_f(g0[0]) * u0[0], silu_f(g0[1]) * u0[1]); w.y = cvt_pk_bf16(silu_f(g0[2]) * u0[2], silu_f(g0[3]) * u0[3]);
                w.z = cvt_pk_bf16(silu_f(g1[0]) * u1[0], silu_f(g1[1]) * u1[1]); w.w = cvt_pk_bf16(silu_f(g1[2]) * u1[2], silu_f(g1[3]) * u1[3]);
                *(u32x4*)rowp = w; }
    }
};
typedef unsigned u32x2 __attribute__((ext_vector_type(2)));
typedef __bf16 bf16x2b_t __attribute__((ext_vector_type(2)));
__device__ __forceinline__ unsigned cvt_pk_bf16_b(float lo, float hi) { f32x2 v = {lo, hi}; bf16x2b_t r = __builtin_convertvector(v, bf16x2b_t); return __builtin_bit_cast(unsigned, r); }
struct EpiRes {
    static constexpr bool PERM = false, AFTER_DRAIN = true;
    float* x_l; float* x_c; const float* gate; float gs; int nk_full; float* part;
    const float* xin_l; const float* xin_c;
    int fuse, final; bf16_t* H; const float* nsh;
    float* slots; unsigned* cnt;
    __device__ __forceinline__ void operator()(const f32x4 (&acc)[2][2][4][2], const Unit& u, int wr, int wc, int fr, int fq) const {
        const bool lat = u.pm < 64; const int s = lat ? (u.pm >> 3) : 8; const size_t r0 = (size_t)(lat ? u.pm : u.pm - 64) * BM;
        const bool whole = (u.nk == nk_full);
        float* xo = whole ? (lat ? x_l : x_c) + r0 * 1024 : part + ((size_t)u.pt * 2048 + r0) * 512;
        const float* xi = (lat ? xin_l : xin_c) + r0 * 1024;
        const int col0 = u.pn * BM + wc * 32 + 4 * fq;
        f32x4 gv[2][2];
#pragma unroll
        for (int bj = 0; bj < 2; ++bj)
#pragma unroll
            for (int n = 0; n < 2; ++n) gv[bj][n] = *(const f32x4*)(gate + s * 9216 + col0 + bj * HALF + n * 16) * gs;
        if (whole) {
#pragma unroll
            for (int ai = 0; ai < 2; ++ai)
#pragma unroll
                for (int m = 0; m < 4; ++m) { const unsigned off = (unsigned)(ai * HALF + wr * 64 + m * 16 + fr) * 1024u + (unsigned)col0;
#pragma unroll
                    for (int bj = 0; bj < 2; ++bj)
#pragma unroll
                        for (int n = 0; n < 2; ++n) { const f32x4 x = *(const f32x4*)(xi + off + bj * HALF + n * 16);
                            *(f32x4*)(xo + off + bj * HALF + n * 16) = x + gv[bj][n] * acc[ai][bj][m][n]; } }
        } else {
#pragma unroll
            for (int ai = 0; ai < 2; ++ai)
#pragma unroll
                for (int m = 0; m < 4; ++m) { const unsigned off = (unsigned)(ai * HALF + wr * 64 + m * 16 + fr) * 1024u + (unsigned)col0;
#pragma unroll
                    for (int bj = 0; bj < 2; ++bj)
#pragma unroll
                        for (int n = 0; n < 2; ++n) { const f32x4 pv = gv[bj][n] * acc[ai][bj][m][n];
                            u32x2 w2; w2.x = cvt_pk_bf16_b(pv[0], pv[1]); w2.y = cvt_pk_bf16_b(pv[2], pv[3]);
                            *(u32x2*)((bf16_t*)xo + off + bj * HALF + n * 16) = w2; } }
        }
    }
    __device__ __forceinline__ void fused(const f32x4 (&acc)[2][2][4][2], const Unit& u, int wr_, int wc_, int fr_, int fq_, PG8_LAS unsigned char* lds, int wid_, int lane_) const {
        const int tid2 = tid_now(), wid = __builtin_amdgcn_readfirstlane(tid2 >> 6), lane = tid2 & 63, wr = wid >> 2, wc = wid & 3, fr = lane & 15, fq = lane >> 4;
        const bool whole = (u.nk == nk_full);
        if (!fuse || !whole || u.pm >= 64) { (*this)(acc, u, wr, wc, fr, fq); return; }
        const int s = u.pm >> 3; float* xo = x_l + (size_t)u.pm * BM * 1024;
        const int col0 = u.pn * BM + wc * 32 + 4 * fq;
        PG8_LAS float* P = (PG8_LAS float*)lds;
        PG8_LAS float* S = (PG8_LAS float*)(lds + 8192);
        {   const float* gp = gate + s * 9216 + col0;
#pragma unroll
            for (int ai = 0; ai < 2; ++ai)
#pragma unroll
                for (int m = 0; m < 4; ++m) { const int r = ai * HALF + wr * 64 + m * 16 + fr; const unsigned eo = (unsigned)(u.pm * BM + r) * 1024u + (unsigned)col0;
                    float* xr = x_l + eo; const float* xir = xin_l + eo; float q = 0.f;
#pragma unroll
                    for (int bj = 0; bj < 2; ++bj)
#pragma unroll
                        for (int n = 0; n < 2; ++n) { const f32x4 x = *(const f32x4*)(xir + bj * HALF + n * 16); const f32x4 gvv = *(const f32x4*)(gp + bj * HALF + n * 16) * gs;
                            const f32x4 y = x + gvv * acc[ai][bj][m][n];
                            *(f32x4*)(xr + bj * HALF + n * 16) = y;
                            q += (y[0] * y[0] + y[1] * y[1]) + (y[2] * y[2] + y[3] * y[3]); }
                    q += __shfl_xor(q, 16); q += __shfl_xor(q, 32);
                    if (fq == 0) P[r * 4 + wc] = q;
                    asm volatile("" ::: "memory"); }
        }
        asm volatile("s_waitcnt lgkmcnt(0)" ::: "memory"); __builtin_amdgcn_s_barrier(); asm volatile("" ::: "memory");
        const int tid = wid * 64 + lane;
        if (tid < 256) { const float t = (P[tid * 4 + 0] + P[tid * 4 + 1]) + (P[tid * 4 + 2] + P[tid * 4 + 3]);
            __hip_atomic_store(slots + ((size_t)(u.pm * BM + tid) * 4 + u.pn), t, __ATOMIC_RELAXED, __HIP_MEMORY_SCOPE_AGENT); }
        asm volatile("s_waitcnt vmcnt(0)" ::: "memory");
        if (tid < 256 && lane == 0) __hip_atomic_fetch_add(cnt + 16 * u.pm, 1u, __ATOMIC_RELAXED, __HIP_MEMORY_SCOPE_AGENT);
        if (wid == 0) { unsigned spins = 0;
            while ((unsigned)__builtin_amdgcn_readfirstlane((int)__hip_atomic_load(cnt + 16 * u.pm, __ATOMIC_RELAXED, __HIP_MEMORY_SCOPE_AGENT)) < 16u) { __builtin_amdgcn_s_sleep(2); if (++spins > (1u << 22)) break; }
            __builtin_amdgcn_fence(__ATOMIC_ACQUIRE, "agent"); }
        asm volatile("s_waitcnt vmcnt(0) lgkmcnt(0)" ::: "memory"); __builtin_amdgcn_s_barrier(); asm volatile("" ::: "memory");
        if (tid < 256) { const float* sp = slots + (size_t)(u.pm * BM + tid) * 4; float t = 0.f;
#pragma unroll
            for (int k = 0; k < 4; ++k) t += __hip_atomic_load(sp + k, __ATOMIC_RELAXED, __HIP_MEMORY_SCOPE_AGENT);
            S[tid] = 1.0f / sqrtf(t * (1.0f / 1024.0f) + 1e-6f); }
        asm volatile("s_waitcnt vmcnt(0) lgkmcnt(0)" ::: "memory"); __builtin_amdgcn_s_barrier(); asm volatile("" ::: "memory");
        if (final) {
            f32x4 gg[2][2];
#pragma unroll
            for (int bj = 0; bj < 2; ++bj)
#pragma unroll
                for (int n = 0; n < 2; ++n) gg[bj][n] = *(const f32x4*)(nsh + col0 + bj * HALF + n * 16);
#pragma unroll
            for (int ai = 0; ai < 2; ++ai)
#pragma unroll
                for (int m = 0; m < 4; ++m) { const int r = ai * HALF + wr * 64 + m * 16 + fr; const float rr = S[r]; const size_t off = (size_t)r * 1024 + col0;
#pragma unroll
                    for (int bj = 0; bj < 2; ++bj)
#pragma unroll
                        for (int n = 0; n < 2; ++n) { const f32x4 y = *(const f32x4*)(xo + off + bj * HALF + n * 16); *(f32x4*)(xo + off + bj * HALF + n * 16) = y * rr * gg[bj][n]; }
                    asm volatile("" ::: "memory"); }
        } else {
            const float* shp = nsh + s * 9216 + col0; bf16_t* hb = H + (size_t)u.pm * BM * 1024 + col0;
            f32x4 sh[2][2], sc[2][2];
#pragma unroll
            for (int bj = 0; bj < 2; ++bj)
#pragma unroll
                for (int n = 0; n < 2; ++n) { sh[bj][n] = *(const f32x4*)(shp + bj * HALF + n * 16); sc[bj][n] = *(const f32x4*)(shp + 1024 + bj * HALF + n * 16) + 1.0f; }
#pragma unroll
            for (int ai = 0; ai < 2; ++ai)
#pragma unroll
                for (int m = 0; m < 4; ++m) { const int r = ai * HALF + wr * 64 + m * 16 + fr; const float rr = S[r];
#pragma unroll
                    for (int bj = 0; bj < 2; ++bj)
#pragma unroll
                        for (int n = 0; n < 2; ++n) { const f32x4 y = *(const f32x4*)(xo + (size_t)r * 1024 + col0 + bj * HALF + n * 16); const f32x4 o = y * rr * sc[bj][n] + sh[bj][n];
                            *(unsigned long long*)(hb + (size_t)r * 1024 + bj * HALF + n * 16) = (unsigned long long)cvt_pk_bf16(o[0], o[1]) | ((unsigned long long)cvt_pk_bf16(o[2], o[3]) << 32); }
                    asm volatile("" ::: "memory"); }
        }
    }
};
struct EpiQKV {
    static constexpr bool PERM = true, AFTER_DRAIN = false;
    bf16_t* Qb; bf16_t* Kb; bf16_t* Vtb; const float* rope; const float* qng; const float* kng; PG8_LAS unsigned char* stage;
    __device__ __forceinline__ void operator()(const f32x4 (&acc)[2][2][4][2], const Unit& u, int wr, int wc, int fr, int fq) const {
        constexpr int POSN = 2304;
        const int lane = fq * 16 + fr;
        PG8_LAS unsigned char* slab = stage + (wr * 4 + wc) * 2560;
        const int ch = u.pn * 4 + wc;
        int mixer, kind, hh;
        if (ch < 16) { mixer = ch >> 3; const int cc = ch & 7; kind = cc < 4 ? 0 : (cc < 6 ? 1 : 2); hh = cc < 4 ? cc : (cc < 6 ? cc - 4 : cc - 6); }
        else { const int cc = (ch < 28) ? ch - 16 : ch - 28; mixer = (ch < 28) ? 2 : 3; kind = cc >> 2; hh = cc & 3; }
        const int kvbase = mixer == 0 ? 0 : (mixer == 1 ? 2 : (mixer == 2 ? 4 : 8));
        const bool lat = u.pm < 64; const int b = lat ? (u.pm >> 3) : (u.pm - 64); const int posbase = lat ? (u.pm & 7) * 256 : 2048;
        const bool t32 = (mixer == 3) && (kind < 2);
        int dof[2][2];
#pragma unroll
        for (int bj = 0; bj < 2; ++bj)
#pragma unroll
            for (int n = 0; n < 2; ++n) dof[bj][n] = t32 ? (32 * bj + 16 * (fq >> 1) + 8 * n + 4 * (fq & 1)) : (32 * bj + 16 * n + 4 * fq);
        if (kind == 2) {
            bf16_t* vb = Vtb + (size_t)((kvbase + hh) * 8 + b) * 64 * POSN + (size_t)(posbase + wr * 64) * 64 + lane * 16;
#pragma unroll
            for (int ai = 0; ai < 2; ++ai)
#pragma unroll
                for (int m = 0; m < 4; ++m) {
#pragma unroll
                    for (int bj = 0; bj < 2; ++bj)
#pragma unroll
                        for (int n = 0; n < 2; ++n) { const f32x4 v = acc[ai][bj][m][n]; const int d0 = dof[bj][n];
                            const unsigned w0 = cvt_pk_bf16(v[0], v[1]), w1 = cvt_pk_bf16(v[2], v[3]);
                            PG8_LAS bf16_t* sp = (PG8_LAS bf16_t*)(slab + d0 * 40 + fr * 2);
                            sp[0] = (bf16_t)(w0 & 0xffffu); sp[20] = (bf16_t)(w0 >> 16); sp[40] = (bf16_t)(w1 & 0xffffu); sp[60] = (bf16_t)(w1 >> 16); }
                    asm volatile("" ::: "memory");
                    typedef unsigned long long u64s;
                    const PG8_LAS u64s* rp = (const PG8_LAS u64s*)(slab + lane * 40);
                    const u64s r0 = rp[0], r1 = rp[1], r2 = rp[2], r3 = rp[3];
                    asm volatile("" ::: "memory");
                    bf16_t* dst = vb + (size_t)(ai * HALF + m * 16) * 64;
                    u32x4 o0, o1; o0.x = (unsigned)r0; o0.y = (unsigned)(r0 >> 32); o0.z = (unsigned)r1; o0.w = (unsigned)(r1 >> 32); o1.x = (unsigned)r2; o1.y = (unsigned)(r2 >> 32); o1.z = (unsigned)r3; o1.w = (unsigned)(r3 >> 32);
                    *(u32x4*)dst = o0; *(u32x4*)(dst + 8) = o1; }
            return;
        }
        const float qs = (kind == 0) ? ((mixer == 3 ? 0.17677669529663687f : 0.125f) * 1.44269504f) : 1.0f;
        bf16_t* ob = (kind == 0) ? Qb + (size_t)((mixer * 8 + b) * 4 + hh) * POSN * 64 : Kb + (size_t)((kvbase + hh) * 8 + b) * POSN * 64;
        f32x4 gv[2][2];
        if (mixer == 1) { const float* gp = (kind == 0) ? qng : kng;
#pragma unroll
            for (int bj = 0; bj < 2; ++bj)
#pragma unroll
                for (int n = 0; n < 2; ++n) gv[bj][n] = *(const f32x4*)(gp + dof[bj][n]); }
#pragma unroll
        for (int ai = 0; ai < 2; ++ai)
#pragma unroll
            for (int m = 0; m < 4; ++m) {
                const int pos = posbase + ai * HALF + wr * 64 + m * 16 + fr;
                f32x4 v[2][2];
#pragma unroll
                for (int bj = 0; bj < 2; ++bj)
#pragma unroll
                    for (int n = 0; n < 2; ++n) v[bj][n] = acc[ai][bj][m][n];
                if (mixer == 1) {
                    float ss = 0.f;
#pragma unroll
                    for (int bj = 0; bj < 2; ++bj)
#pragma unroll
                        for (int n = 0; n < 2; ++n) ss += (v[bj][n][0] * v[bj][n][0] + v[bj][n][1] * v[bj][n][1]) + (v[bj][n][2] * v[bj][n][2] + v[bj][n][3] * v[bj][n][3]);
                    ss += __shfl_xor(ss, 16); ss += __shfl_xor(ss, 32);
                    const float rr = 1.0f / sqrtf(ss * (1.0f / 64.0f) + 1e-6f);
#pragma unroll
                    for (int bj = 0; bj < 2; ++bj)
#pragma unroll
                        for (int n = 0; n < 2; ++n) v[bj][n] = v[bj][n] * rr * gv[bj][n];
                }
                if (lat && mixer < 2) {
                    const int grow = pos >> 6, gcol = pos & 63;
#pragma unroll
                    for (int bj = 0; bj < 2; ++bj) { const float* rp = rope + (bj ? gcol : grow) * 16 + 4 * fq;
                        const f32x4 c4 = *(const f32x4*)rp, s4 = *(const f32x4*)(rp + 1024);
                        const f32x4 x0 = v[bj][0], x1 = v[bj][1];
                        v[bj][0] = x0 * c4 - x1 * s4; v[bj][1] = x1 * c4 + x0 * s4; }
                } else if (lat && mixer == 3) {
                    const int p = (fq & 2) ? (pos & 63) : (pos >> 6);
                    const float* rp = rope + 2048 + p * 8 + 4 * (fq & 1); const f32x4 c4 = *(const f32x4*)rp, s4 = *(const f32x4*)(rp + 512);
#pragma unroll
                    for (int bj = 0; bj < 2; ++bj) { const f32x4 x0 = v[bj][0], x1 = v[bj][1];
                        v[bj][0] = x0 * c4 - x1 * s4; v[bj][1] = x1 * c4 + x0 * s4; }
                }
#pragma unroll
                for (int bj = 0; bj < 2; ++bj)
#pragma unroll
                    for (int n = 0; n < 2; ++n) { const f32x4 a = v[bj][n] * qs;
                        *(PG8_LAS unsigned long long*)(slab + fr * 136 + dof[bj][n] * 2) = (unsigned long long)cvt_pk_bf16(a[0], a[1]) | ((unsigned long long)cvt_pk_bf16(a[2], a[3]) << 32); }
                asm volatile("" ::: "memory");
                typedef unsigned long long u64s;
                const PG8_LAS u64s* rp = (const PG8_LAS u64s*)(slab + (lane >> 2) * 136 + (lane & 3) * 32);
                const u64s r0 = rp[0], r1 = rp[1], r2 = rp[2], r3 = rp[3];
                asm volatile("" ::: "memory");
                bf16_t* dst = ob + (size_t)(posbase + ai * HALF + wr * 64 + m * 16) * 64 + lane * 16;
                u32x4 o0, o1; o0.x = (unsigned)r0; o0.y = (unsigned)(r0 >> 32); o0.z = (unsigned)r1; o0.w = (unsigned)(r1 >> 32); o1.x = (unsigned)r2; o1.y = (unsigned)(r2 >> 32); o1.z = (unsigned)r3; o1.w = (unsigned)(r3 >> 32);
                *(u32x4*)dst = o0; *(u32x4*)(dst + 8) = o1;
            }
    }
};
struct SplitOrder {
    StaticOrder so; int P;
    __host__ __device__ void init(int M, int N, int G_, int c_, int K_) {
        P = (M == 18432 && N == 1024 && G_ == 256 && (K_ / BK) >= 16) ? 8 : 0;
#ifdef NO_SPLIT
        P = 0;
#endif
        so.init(P ? 16384 : M, N, G_, c_, K_);
    }
    __host__ __device__ bool next(int i, Unit& u) const {
        Unit a; a.pm = 0; a.pn = 0; a.k0 = 0; a.nk = so.nK; a.pt = 0;
        bool ok;
        if (P == 0) ok = so.next(i, a);
        else {
            ok = so.next(0, a) && (i <= 1);
            if (i == 0) {
                const int t = so.c >> 3, p = so.c & 7, h = so.nK / 2, q = h / P, r = h % P;
                a.pm = 64 + (t >> 2); a.pn = t & 3; a.pt = p;
                a.k0 = 2 * (p * q + (p < r ? p : r)); a.nk = 2 * (q + (p < r ? 1 : 0));
            }
        }
        u = a; return ok;
    }
    __device__ __forceinline__ void a_ready(const Unit&) const {}
    __device__ __forceinline__ void done(const Unit&) const {}
};
}

#define LAS __attribute__((address_space(3)))
typedef unsigned short bf16_t;
typedef short bf16x8 __attribute__((ext_vector_type(8)));
typedef float f32x4 __attribute__((ext_vector_type(4)));
typedef unsigned u32x4 __attribute__((ext_vector_type(4)));
typedef unsigned u32x2 __attribute__((ext_vector_type(2)));
constexpr int NT = 512;
constexpr int DM = 1024, SEQ = 2048, NBATCH = 8, CTXL = 256, DFF = 2816, INW = 2560;
constexpr int ML = NBATCH * SEQ, MC = NBATCH * CTXL, MT = ML + MC;
constexpr int POS = SEQ + CTXL;
constexpr float LOG2E = 1.44269504f;
constexpr int LDS_BYTES = 152576;
#ifndef REP_SYNC
#define REP_SYNC 1
#endif
#define GSYNC() do { for (int r_ = 0; r_ < REP_SYNC; ++r_) { XcdBarrier xb_; xb_.bar = (unsigned*)(ldws() + WS_BAR); xb_.x = xb_xcc_id(); xb_.st = (volatile LAS unsigned*)(lds + MISC_OFF); xcd_barrier(xb_); } } while (0)
constexpr int MISC_OFF = LDS_BYTES - 64;
#ifdef NO_SPLIT
#define SPLIT_PART ((const float*)nullptr)
#else
#define SPLIT_PART ((GRD == 256) ? (const float*)WSF(WS_Q) : (const float*)nullptr)
#endif
#ifndef REP_ATT
#define REP_ATT 1
#endif
#ifndef REP_LIGHT
#define REP_LIGHT 1
#endif
#ifndef REP_GU
#define REP_GU 1
#endif
constexpr size_t MiB = 1u << 20;
constexpr size_t WS_CTL = 0, WS_BAR = 16384, WS_CNT = 32768, CTL_ZERO_BYTES = 65536, WS_ROPE = 65536, WS_SCAL = 131072, WS_MOD = 262144;
constexpr size_t WS_W = 1 * MiB;
constexpr size_t W_GU1 = 0, W_D1 = 11 * MiB, W_IN = 16 * MiB + 512 * 1024, W_OUT = 21 * MiB + 512 * 1024, W_GU2 = 23 * MiB + 512 * 1024, W_D2 = 34 * MiB + 512 * 1024;
constexpr size_t WS_XC = 41 * MiB, WS_H = 49 * MiB, WS_G = 85 * MiB, WS_Q = 184 * MiB, WS_K = 220 * MiB, WS_VT = 247 * MiB, WS_SLOTS = 274 * MiB, WS_END = 275 * MiB;

__device__ __forceinline__ float bf2f(bf16_t v) { return __builtin_bit_cast(float, (unsigned)v << 16); }
__device__ __forceinline__ unsigned pk2(float lo, float hi) { return pg8::cvt_pk_bf16(lo, hi); }
__device__ __forceinline__ bf16_t f2bf(float v) { return (bf16_t)(pk2(v, 0.f) & 0xffffu); }
__device__ __forceinline__ float wave_sum(float v) {
#pragma unroll
    for (int o = 1; o < 64; o <<= 1) v += __shfl_xor(v, o);
    return v;
}
#define LDS_WAIT() asm volatile("s_waitcnt lgkmcnt(0)" ::: "memory")
#define XB_TMO      128
#define XB_XCNT(j)  (256  + 64 * (j))
#define XB_XSUB(j)  (1280 + 64 * (j))
#define XB_XGEN(j)  (2304 + 64 * (j))
#define XB_TOP      3328
#define XB_TOPGEN   3392
#define XCD_BAR_WORDS 3456
#define XB_SPIN_CAP (1u << 18)

__device__ __forceinline__ unsigned xb_ld(unsigned* p)              { return __hip_atomic_load(p, __ATOMIC_RELAXED, __HIP_MEMORY_SCOPE_AGENT); }
__device__ __forceinline__ unsigned xb_add(unsigned* p, unsigned v) { return __hip_atomic_fetch_add(p, v, __ATOMIC_RELAXED, __HIP_MEMORY_SCOPE_AGENT); }
__device__ __forceinline__ unsigned xb_xcc_id() { return (unsigned)__builtin_amdgcn_s_getreg((3 << 11) | 20) & 0xFu; }
#define XB_SPIN(cond, bar) do { unsigned _sp = 0; while (cond) { __builtin_amdgcn_s_sleep(1); \
    if ((++_sp & 255u) == 0u) { if (xb_ld(&(bar)[XB_TMO])) break; if (_sp > XB_SPIN_CAP) { atomicAdd(&(bar)[XB_TMO], 1u); break; } } } } while (0)

struct XcdBarrier {
    unsigned* bar; unsigned x;
    volatile LAS unsigned* st;
};

__device__ __forceinline__ XcdBarrier xcd_barrier_post(unsigned* bar, volatile LAS unsigned* st) {
    XcdBarrier b; b.bar = bar; b.x = xb_xcc_id(); b.st = st;
    if (threadIdx.x == 0) (void)xb_add(&bar[XB_XCNT(b.x)], 1u);
    return b;
}
__device__ __forceinline__ void xcd_barrier_complete(unsigned* bar, unsigned x, unsigned& nloc, unsigned& nx) {
    const unsigned G = gridDim.x * gridDim.y * gridDim.z;
    unsigned sum, cnt, mine, sp = 0u;
    for (;;) {
        sum = 0u; cnt = 0u; mine = 0u;
#pragma unroll
        for (unsigned j = 0; j < 16; ++j) { const unsigned c = xb_ld(&bar[XB_XCNT(j)]); sum += c; cnt += (c > 0u) ? 1u : 0u; mine = (j == x) ? c : mine; }
        if (sum == G) break;
        __builtin_amdgcn_s_sleep(1);
        if ((++sp & 255u) == 0u) { if (xb_ld(&bar[XB_TMO])) break; if (sp > XB_SPIN_CAP) { atomicAdd(&bar[XB_TMO], 1u); break; } }
    }
    nloc = mine > 0u ? mine : 1u; nx = cnt > 0u ? cnt : 1u;
}

__device__ __forceinline__ void xcd_barrier(const XcdBarrier& b) {
    asm volatile("s_waitcnt vmcnt(0)" ::: "memory");
    __syncthreads();
    if (threadIdx.x == 0) {
        unsigned* bar = b.bar;
        __builtin_amdgcn_s_waitcnt(0);
        unsigned nloc = b.st[0], nx = b.st[1];
        if (nloc == 0u) { xcd_barrier_complete(bar, b.x, nloc, nx); b.st[0] = nloc; b.st[1] = nx; }
        const unsigned old = xb_add(&bar[XB_XSUB(b.x)], 1u);
        const unsigned gen = old / nloc;
        if (old + 1u == (gen + 1u) * nloc) {
            __builtin_amdgcn_fence(__ATOMIC_RELEASE, "agent");
            asm volatile("s_waitcnt vmcnt(0)" ::: "memory");
            const unsigned og = xb_add(&bar[XB_TOP], 1u);
            const unsigned tg = og / nx;
            if (og + 1u == (tg + 1u) * nx) xb_add(&bar[XB_TOPGEN], 1u);
            else XB_SPIN(xb_ld(&bar[XB_TOPGEN]) == tg, bar);
            __builtin_amdgcn_fence(__ATOMIC_ACQUIRE, "agent");
            xb_add(&bar[XB_XGEN(b.x)], 1u);
            asm volatile("s_waitcnt vmcnt(0)" ::: "memory");
        } else {
            XB_SPIN(xb_ld(&bar[XB_XGEN(b.x)]) == gen, bar);
            __builtin_amdgcn_fence(__ATOMIC_ACQUIRE, "agent");
            asm volatile("s_waitcnt vmcnt(0)" ::: "memory");
        }
    }
    __syncthreads();
}


__device__ __forceinline__ void p0_mod(LAS unsigned char* lds, const float* c, const float* cctx, const float* w_ada, const float* b_ada, float* MOD, int bid, int G, int tid) {
    LAS float* sl = (LAS float*)lds;
    LAS float* red = (LAS float*)(lds + 36864);
    for (int i = tid; i < 9 * 1024; i += NT) { const float v = i < 8192 ? c[i] : cctx[i - 8192]; sl[i] = v / (1.0f + expf(-v)); }
    __syncthreads();
    const int col = tid & 63, kg = tid >> 6;
    for (int item = bid; item < 2 * 144; item += G) {
        const int l = item / 144, n0 = (item % 144) * 64;
        const float* w = w_ada + (size_t)l * 1024 * 9216 + n0 + col;
        float acc[9];
#pragma unroll
        for (int s = 0; s < 9; ++s) acc[s] = 0.f;
#pragma unroll 16
        for (int k = kg * 128; k < kg * 128 + 128; ++k) { const float wv = __builtin_nontemporal_load(&w[(size_t)k * 9216]);
#pragma unroll
            for (int s = 0; s < 9; ++s) acc[s] += sl[s * 1024 + k] * wv; }
#pragma unroll
        for (int s = 0; s < 9; ++s) red[(kg * 9 + s) * 64 + col] = acc[s];
        __syncthreads();
        for (int i = tid; i < 9 * 64; i += NT) { const int s = i >> 6, cc = i & 63; float v = b_ada[l * 9216 + n0 + cc];
#pragma unroll
            for (int g = 0; g < 8; ++g) v += red[(g * 9 + s) * 64 + cc];
            MOD[((size_t)l * 9 + s) * 9216 + n0 + cc] = v; }
        __syncthreads();
    }
}
__device__ __forceinline__ void p0_misc(float* rope, float* scal, const float* lq1, const float* lk1, const float* lq2, const float* lk2, int tid) {
    for (int i = tid; i < 1024; i += NT) { const int p = i >> 4, f = i & 15; const float fr = exp2f(-(float)f * (13.287712379549449f / 16.0f)); const float a = (float)p * fr; rope[i] = __cosf(a); rope[1024 + i] = __sinf(a); }
    for (int i = tid; i < 512; i += NT) { const int p = i >> 3, f = i & 7; const float fr = exp2f(-(float)f * (13.287712379549449f / 8.0f)); const float a = (float)p * fr; rope[2048 + i] = __cosf(a); rope[2560 + i] = __sinf(a); }
    if (tid < 2) { const int l = tid; float d1 = 0.f, d2 = 0.f;
        for (int k = 0; k < 32; ++k) { d1 += lq1[l * 32 + k] * lk1[l * 32 + k]; d2 += lq2[l * 32 + k] * lk2[l * 32 + k]; }
        const float lam_init = 0.8f - 0.6f * expf(-0.3f * (float)l);
        scal[l] = expf(d1) - expf(d2) + lam_init; }
}

__device__ __forceinline__ void transpose_item(const float* W, int K, int N, bf16_t* WT, int mode, LAS float* scr, int item, int lane) {
    const int nblk = N / 32, kb = item / nblk, nb = item % nblk, k0 = 64 * kb, n0 = 32 * nb;
    const int g8 = (n0 >> 5) & 7;
    const int drow0 = mode == 0 ? n0 : (mode == 3 ? ((n0 & ~255) + 32 * (4 * (g8 & 1) + (g8 >> 1))) : ((n0 >> 7) * 256 + (n0 & 127) + (mode == 2 ? 128 : 0)));
    float wv[32];
#pragma unroll
    for (int i = 0; i < 32; ++i) wv[i] = __builtin_nontemporal_load(&W[(size_t)(k0 + 2 * i + (lane >> 5)) * N + n0 + (lane & 31)]);
#pragma unroll
    for (int i = 0; i < 32; ++i) scr[(2 * i + (lane >> 5)) * 33 + (lane & 31)] = wv[i];
    LDS_WAIT(); asm volatile("" ::: "memory");
    const int c = lane & 7;
#pragma unroll
    for (int j = 0; j < 4; ++j) { const int n = (lane >> 3) + 8 * j; const LAS float* s = scr + (8 * c) * 33 + n;
        u32x4 o; o.x = pk2(s[0 * 33], s[1 * 33]); o.y = pk2(s[2 * 33], s[3 * 33]); o.z = pk2(s[4 * 33], s[5 * 33]); o.w = pk2(s[6 * 33], s[7 * 33]);
        int nn = n;
        if (mode == 3) { const bool t32 = (n0 >> 6) >= 28 && (n0 >> 6) < 36;
            nn = t32 ? (8 * (2 * ((n >> 4) & 1) + ((n >> 2) & 1)) + 4 * ((n >> 3) & 1) + (n & 3)) : (8 * ((n >> 2) & 3) + 4 * (n >> 4) + (n & 3)); }
        *(u32x4*)(WT + (size_t)(drow0 + nn) * K + k0 + 8 * c) = o; }
    LDS_WAIT(); asm volatile("" ::: "memory");
}
__device__ __forceinline__ void convert_layer(LAS unsigned char* lds, int l, const float* g1, const float* u1, const float* d1, const float* win, const float* wout,
                                              const float* g2, const float* u2, const float* d2, unsigned char* wsW, int gw, int NGW, int wave, int lane) {
    LAS float* scr = (LAS float*)(lds + wave * 8448);
    const size_t offF = (size_t)l * DM * DFF;
    constexpr int I_GU = 16 * 88, I_D = 44 * 32, I_IN = 16 * 80, I_OUT = 16 * 32;
    constexpr int NITEMS = 6 * I_GU + I_IN + I_OUT;
    for (int it = gw; it < NITEMS; it += NGW) {
        int r = it;
        if (r < I_GU) { transpose_item(g1 + offF, DM, DFF, (bf16_t*)(wsW + W_GU1), 1, scr, r, lane); continue; } r -= I_GU;
        if (r < I_GU) { transpose_item(u1 + offF, DM, DFF, (bf16_t*)(wsW + W_GU1), 2, scr, r, lane); continue; } r -= I_GU;
        if (r < I_D)  { transpose_item(d1 + offF, DFF, DM, (bf16_t*)(wsW + W_D1), 0, scr, r, lane); continue; } r -= I_D;
        if (r < I_GU) { transpose_item(g2 + offF, DM, DFF, (bf16_t*)(wsW + W_GU2), 1, scr, r, lane); continue; } r -= I_GU;
        if (r < I_GU) { transpose_item(u2 + offF, DM, DFF, (bf16_t*)(wsW + W_GU2), 2, scr, r, lane); continue; } r -= I_GU;
        if (r < I_D)  { transpose_item(d2 + offF, DFF, DM, (bf16_t*)(wsW + W_D2), 0, scr, r, lane); continue; } r -= I_D;
        if (r < I_IN) { transpose_item(win + (size_t)l * DM * INW, DM, INW, (bf16_t*)(wsW + W_IN), 3, scr, r, lane); continue; } r -= I_IN;
        transpose_item(wout + (size_t)l * DM * DM, DM, DM, (bf16_t*)(wsW + W_OUT), 0, scr, r, lane);
    }
}

__device__ __forceinline__ void norm_mod_row(const float* xr, float* cp, bf16_t* hrow, const float* sh, const float* sc, int lane) {
    f32x4 v[4]; float ss = 0.f;
#pragma unroll
    for (int j = 0; j < 4; ++j) { v[j] = *(const f32x4*)(xr + 4 * lane + 256 * j); ss += (v[j].x * v[j].x + v[j].y * v[j].y) + (v[j].z * v[j].z + v[j].w * v[j].w); }
    if (cp) {
#pragma unroll
        for (int j = 0; j < 4; ++j) *(f32x4*)(cp + 4 * lane + 256 * j) = v[j];
    }
    ss = wave_sum(ss);
    const float rr = 1.0f / sqrtf(ss * (1.0f / DM) + 1e-6f);
    unsigned long long* o8 = (unsigned long long*)hrow + lane;
#pragma unroll
    for (int j = 0; j < 4; ++j) { const f32x4 a = *(const f32x4*)(sh + 4 * lane + 256 * j), b = *(const f32x4*)(sc + 4 * lane + 256 * j);
        const f32x4 o = v[j] * rr * (b + 1.0f) + a;
        o8[64 * j] = (unsigned long long)pk2(o.x, o.y) | ((unsigned long long)pk2(o.z, o.w) << 32); }
}
__device__ __forceinline__ void norm_mod_phase(const float* xl, const float* xc, float* cpl, float* cpc, const float* part, float* xcw, bf16_t* H, const float* modl, int sidx, int rbegin, int nrows, int gw, int ngw, int lane) {
    for (int r = rbegin + gw; r < nrows; r += 2 * ngw) {
        const int r2 = r + ngw; const bool two = r2 < nrows;
        const bool lat = r < ML; const size_t ro = lat ? (size_t)r * DM : (size_t)(r - ML) * DM; const int s = lat ? (r >> 11) : 8;
        const float* sh = modl + s * 9216 + sidx * 1024;
        const bool lat2 = r2 < ML; const size_t ro2 = lat2 ? (size_t)r2 * DM : (size_t)(r2 - ML) * DM; const int s2 = lat2 ? (r2 >> 11) : 8;
        const float* sh2 = modl + s2 * 9216 + sidx * 1024;
        const float* xr = (lat ? xl : xc) + ro; const float* xr2 = (lat2 ? xl : xc) + ro2;
        f32x4 v[4], w[4]; float ss = 0.f, ss2 = 0.f;
#pragma unroll
        for (int j = 0; j < 4; ++j) { v[j] = __builtin_nontemporal_load((const f32x4*)(xr + 4 * lane + 256 * j)); }
        if (two) {
#pragma unroll
            for (int j = 0; j < 4; ++j) { w[j] = __builtin_nontemporal_load((const f32x4*)(xr2 + 4 * lane + 256 * j)); }
        } else {
#pragma unroll
            for (int j = 0; j < 4; ++j) w[j] = (f32x4){0.f, 0.f, 0.f, 0.f};
        }
        if (part && !lat) {
#pragma unroll
            for (int p = 0; p < 8; ++p) { const bf16_t* pp = (const bf16_t*)part + (size_t)p * 2048 * 1024 + ro;
#pragma unroll
                for (int j = 0; j < 4; ++j) { const u32x2 q = *(const u32x2*)(pp + 4 * lane + 256 * j);
                    v[j] += (f32x4){__builtin_bit_cast(float, q.x << 16), __builtin_bit_cast(float, q.x & 0xffff0000u), __builtin_bit_cast(float, q.y << 16), __builtin_bit_cast(float, q.y & 0xffff0000u)}; } }
            float* cp = xcw + ro;
#pragma unroll
            for (int j = 0; j < 4; ++j) *(f32x4*)(cp + 4 * lane + 256 * j) = v[j];
        }
        if (part && two && !lat2) {
#pragma unroll
            for (int p = 0; p < 8; ++p) { const bf16_t* pp = (const bf16_t*)part + (size_t)p * 2048 * 1024 + ro2;
#pragma unroll
                for (int j = 0; j < 4; ++j) { const u32x2 q = *(const u32x2*)(pp + 4 * lane + 256 * j);
                    w[j] += (f32x4){__builtin_bit_cast(float, q.x << 16), __builtin_bit_cast(float, q.x & 0xffff0000u), __builtin_bit_cast(float, q.y << 16), __builtin_bit_cast(float, q.y & 0xffff0000u)}; } }
            float* cp = xcw + ro2;
#pragma unroll
            for (int j = 0; j < 4; ++j) *(f32x4*)(cp + 4 * lane + 256 * j) = w[j];
        }
#pragma unroll
        for (int j = 0; j < 4; ++j) { ss += (v[j].x * v[j].x + v[j].y * v[j].y) + (v[j].z * v[j].z + v[j].w * v[j].w); ss2 += (w[j].x * w[j].x + w[j].y * w[j].y) + (w[j].z * w[j].z + w[j].w * w[j].w); }
        if (cpl) { float* cp = (lat ? cpl : cpc) + ro;
#pragma unroll
            for (int j = 0; j < 4; ++j) *(f32x4*)(cp + 4 * lane + 256 * j) = v[j];
            if (two) { float* cp2 = (lat2 ? cpl : cpc) + ro2;
#pragma unroll
                for (int j = 0; j < 4; ++j) *(f32x4*)(cp2 + 4 * lane + 256 * j) = w[j]; } }
#pragma unroll
        for (int o = 1; o < 64; o <<= 1) { ss += __shfl_xor(ss, o); ss2 += __shfl_xor(ss2, o); }
        const float rr = 1.0f / sqrtf(ss * (1.0f / DM) + 1e-6f), rr2 = 1.0f / sqrtf(ss2 * (1.0f / DM) + 1e-6f);
        unsigned long long* o8 = (unsigned long long*)(H + (size_t)r * DM) + lane;
#pragma unroll
        for (int j = 0; j < 4; ++j) { const f32x4 a = *(const f32x4*)(sh + 4 * lane + 256 * j), b = *(const f32x4*)(sh + 1024 + 4 * lane + 256 * j);
            const f32x4 o = v[j] * rr * (b + 1.0f) + a;
            o8[64 * j] = (unsigned long long)pk2(o.x, o.y) | ((unsigned long long)pk2(o.z, o.w) << 32); }
        if (two) { unsigned long long* p8 = (unsigned long long*)(H + (size_t)r2 * DM) + lane;
#pragma unroll
            for (int j = 0; j < 4; ++j) { const f32x4 a = *(const f32x4*)(sh2 + 4 * lane + 256 * j), b = *(const f32x4*)(sh2 + 1024 + 4 * lane + 256 * j);
                const f32x4 o = w[j] * rr2 * (b + 1.0f) + a;
                p8[64 * j] = (unsigned long long)pk2(o.x, o.y) | ((unsigned long long)pk2(o.z, o.w) << 32); } }
    }
}
__device__ __forceinline__ void final_norm_phase(float* x, const float* g, int gw, int NGW, int lane) {
    for (int r = gw; r < ML; r += NGW) {
        float* xr = x + (size_t)r * DM;
        f32x4 v[4]; float ss = 0.f;
#pragma unroll
        for (int j = 0; j < 4; ++j) { v[j] = *(const f32x4*)(xr + 4 * lane + 256 * j); ss += (v[j].x * v[j].x + v[j].y * v[j].y) + (v[j].z * v[j].z + v[j].w * v[j].w); }
        ss = wave_sum(ss);
        const float rr = 1.0f / sqrtf(ss * (1.0f / DM) + 1e-6f);
#pragma unroll
        for (int j = 0; j < 4; ++j) { const f32x4 a = *(const f32x4*)(g + 4 * lane + 256 * j); *(f32x4*)(xr + 4 * lane + 256 * j) = v[j] * rr * a; }
    }
}

__device__ __forceinline__ void qkv_post_phase(LAS unsigned char* lds, const bf16_t* QKV, bf16_t* Qb, bf16_t* Kb, bf16_t* Vtb, const float* rope, const float* qng, const float* kng,
                                               int bid, int G, int tid, int lane, int wave) {
    LAS bf16_t* T = (LAS bf16_t*)lds;
    const float qg = qng[lane], kg = kng[lane];
    for (int item = bid; item < MT / 32; item += G) {
        const int row0 = item * 32; const bool lat = row0 < ML;
        const int b = lat ? (row0 >> 11) : ((row0 - ML) >> 8);
        const int pos0 = lat ? (row0 & 2047) : 2048 + ((row0 - ML) & 255);
        for (int rr = 0; rr < 4; ++rr) {
            const int tl = wave * 4 + rr, row = row0 + tl, pos = pos0 + tl;
            const int grow = (pos >> 6) & 31, gcol = pos & 63;
            const bf16_t* src = QKV + (size_t)row * INW + lane;
            const int p64 = (lane < 32) ? grow : gcol; const float c64 = rope[p64 * 16 + (lane & 15)], s64 = rope[1024 + p64 * 16 + (lane & 15)];
            const int p32 = (lane & 16) ? gcol : grow; const float c32 = rope[2048 + p32 * 8 + (lane & 7)], s32 = rope[2560 + p32 * 8 + (lane & 7)];
#pragma unroll 1
            for (int ch = 0; ch < 40; ++ch) {
                int mixer, kind, hh;
                if (ch < 16) { mixer = ch >> 3; const int cc = ch & 7; kind = cc < 4 ? 0 : (cc < 6 ? 1 : 2); hh = cc < 4 ? cc : (cc < 6 ? cc - 4 : cc - 6); }
                else { const int cc = (ch < 28) ? ch - 16 : ch - 28; mixer = (ch < 28) ? 2 : 3; kind = cc >> 2; hh = cc & 3; }
                const int kvbase = mixer == 0 ? 0 : (mixer == 1 ? 2 : (mixer == 2 ? 4 : 8));
                const bf16_t raw = src[ch * 64];
                if (kind == 2) { T[((kvbase + hh) * 64 + lane) * 34 + tl] = raw; continue; }
                float v = bf2f(raw);
                if (mixer == 1) { const float ss = wave_sum(v * v); v = v * (1.0f / sqrtf(ss * (1.0f / 64.0f) + 1e-6f)) * (kind == 0 ? qg : kg); }
                if (lat && mixer < 2) { const float pr = __shfl_xor(v, 16); v = v * c64 + ((lane & 16) ? pr : -pr) * s64; }
                else if (lat && mixer == 3) { const float pr = __shfl_xor(v, 8); v = v * c32 + ((lane & 8) ? pr : -pr) * s32; }
                if (kind == 0) { v *= (mixer == 3 ? 0.17677669529663687f : 0.125f) * LOG2E;
                    Qb[((size_t)((mixer * 8 + b) * 4 + hh) * POS + pos) * 64 + lane] = f2bf(v); }
                else Kb[((size_t)((kvbase + hh) * 8 + b) * POS + pos) * 64 + lane] = f2bf(v);
            }
        }
        __syncthreads();
#pragma unroll 1
        for (int p = 0; p < 6; ++p) { const int task = p * NT + tid, rowi = task >> 2, k = task & 3; const int c12 = rowi >> 6, d = rowi & 63;
            const LAS bf16_t* s = T + rowi * 34 + 8 * k;
            u32x4 o; o.x = (unsigned)s[0] | ((unsigned)s[1] << 16); o.y = (unsigned)s[2] | ((unsigned)s[3] << 16); o.z = (unsigned)s[4] | ((unsigned)s[5] << 16); o.w = (unsigned)s[6] | ((unsigned)s[7] << 16);
            *(u32x4*)(Vtb + ((size_t)(c12 * 8 + b) * 64 + d) * POS + pos0 + 8 * k) = o; }
        __syncthreads();
    }
}

#define MFMA16(a, b, c) __builtin_amdgcn_mfma_f32_16x16x32_bf16(a, b, c, 0, 0, 0)
constexpr int KSTR = 72;
constexpr int ABUF_BYTES = 2 * 64 * KSTR * 2;
constexpr int ATT_BIAS_OFF = 2 * ABUF_BYTES, ATT_CUR_OFF = ATT_BIAS_OFF + 2048;
constexpr float RESCALE_TH = 8.0f;
typedef float f32x2_t __attribute__((ext_vector_type(2)));
typedef __bf16 bf16x2_t __attribute__((ext_vector_type(2)));
__device__ __forceinline__ unsigned pk2v(float lo, float hi) { f32x2_t v = {lo, hi}; bf16x2_t b = __builtin_convertvector(v, bf16x2_t); return __builtin_bit_cast(unsigned, b); }
__device__ __forceinline__ float max3f(float a, float b, float c) { float r; asm("v_max3_f32 %0, %1, %2, %3" : "=v"(r) : "v"(a), "v"(b), "v"(c)); return r; }

template <bool DIFF>
__device__ __forceinline__ void attn_unit(LAS unsigned char* lds, const bf16_t* __restrict__ Qp, const bf16_t* __restrict__ Kp, const bf16_t* __restrict__ Vp, bf16_t* __restrict__ Yp,
                                          int q0, int ntiles, int nfirst, int firstpos, int secondpos, int maskmode, float m_init, bool sinkf, const LAS float* bias,
                                          float lam, const float* subg, float oscale, int wave) {
    constexpr int NB = DIFF ? 2 : 1;
    const int tid = tid_now(), lane = tid & 63;
    const int fr = lane & 15, fq = lane >> 4;
    const int sr = tid >> 3, sc = (tid & 7) * 8;
    const int vgo = tid * 8;
    const unsigned vst = 9216u + (unsigned)((((tid >> 1) & 63) * KSTR) + (tid >> 7) * 16 + (tid & 1) * 8) * 2u;
    const int qbase = q0 + wave * 32 + fr;
    bf16x8 qf[2][2];
#pragma unroll
    for (int qg = 0; qg < 2; ++qg) { qf[qg][0] = *(const bf16x8*)(Qp + (size_t)(qbase + 16 * qg) * 64 + fq * 8); qf[qg][1] = *(const bf16x8*)(Qp + (size_t)(qbase + 16 * qg) * 64 + 32 + fq * 8); }
    f32x4 o[2][NB][4], l[2][NB]; float m[2][NB];
    const bf16x8 ones = (bf16x8){16256, 16256, 16256, 16256, 16256, 16256, 16256, 16256};
#pragma unroll
    for (int qg = 0; qg < 2; ++qg)
#pragma unroll
        for (int br = 0; br < NB; ++br) { m[qg][br] = (br == 0) ? m_init : -1e30f; { const float l0 = (br == 0 && sinkf) ? 1.f : 0.f; l[qg][br] = (f32x4){l0, l0, l0, l0}; }
#pragma unroll
            for (int dg = 0; dg < 4; ++dg) o[qg][br][dg] = (f32x4){0.f, 0.f, 0.f, 0.f}; }
    const unsigned stoff = (unsigned)(sr * KSTR + sc) * 2u;
#define TILEPOS(t) (((t) < nfirst) ? firstpos + 64 * (t) : secondpos + 64 * ((t) - nfirst))
    u32x4 kA, vA, kB, vB;
    kB = *(const u32x4*)(Kp + (size_t)(firstpos + sr) * 64 + sc); vB = *(const u32x4*)(Vp + (size_t)firstpos * 64 + vgo);
    { const int p1 = (1 < ntiles) ? TILEPOS(1) : firstpos; kA = *(const u32x4*)(Kp + (size_t)(p1 + sr) * 64 + sc); vA = *(const u32x4*)(Vp + (size_t)p1 * 64 + vgo); }
    *(LAS u32x4*)(lds + stoff) = kB; *(LAS u32x4*)(lds + vst) = vB;
    __syncthreads();
#pragma unroll 1
    for (int i2 = 0; i2 < ntiles; i2 += 2) {
        {   const int i = i2; const int buf = i & 1, curpos = TILEPOS(i); const bool more = (i + 1) < ntiles;
            { const int pos2 = (i + 2 < ntiles) ? TILEPOS(i + 2) : curpos;
              kB = *(const u32x4*)(Kp + (size_t)(pos2 + sr) * 64 + sc); vB = *(const u32x4*)(Vp + (size_t)pos2 * 64 + vgo); }
        const LAS unsigned char* Kt = lds + buf * ABUF_BYTES; const LAS unsigned char* Vt = Kt + 9216;
        float mf[2][NB]; f32x4 s[2][NB][4];
#pragma unroll
        for (int qg = 0; qg < 2; ++qg)
#pragma unroll
            for (int br = 0; br < NB; ++br) mf[qg][br] = (m[qg][br] < -1e29f) ? 0.f : m[qg][br];
        bf16x8 kfr[8];
#pragma unroll
        for (int g = 0; g < 4; ++g) { kfr[2 * g] = *(const LAS bf16x8*)(Kt + ((16 * g + fr) * KSTR + fq * 8) * 2); kfr[2 * g + 1] = *(const LAS bf16x8*)(Kt + ((16 * g + fr) * KSTR + 32 + fq * 8) * 2); }
        __builtin_amdgcn_sched_barrier(0);
#pragma unroll
        for (int g = 0; g < 4; ++g) {
            const bf16x8 k0 = kfr[2 * g], k1 = kfr[2 * g + 1];
#pragma unroll
            for (int qg = 0; qg < 2; ++qg) {
                const float c0 = -mf[qg][0];
                if (DIFF) { const float c1 = -mf[qg][NB - 1];
                    s[qg][0][g] = MFMA16(k0, qf[qg][0], ((f32x4){c0, c0, c0, c0})); s[qg][NB - 1][g] = MFMA16(k1, qf[qg][1], ((f32x4){c1, c1, c1, c1})); }
                else { s[qg][0][g] = MFMA16(k0, qf[qg][0], ((f32x4){c0, c0, c0, c0})); s[qg][0][g] = MFMA16(k1, qf[qg][1], s[qg][0][g]); }
            }
        }
        if (!DIFF && maskmode != 0 && i >= nfirst) {
            if (maskmode == 1) {
#pragma unroll
                for (int qg = 0; qg < 2; ++qg)
#pragma unroll
                    for (int g = 0; g < 4; ++g)
#pragma unroll
                        for (int j = 0; j < 4; ++j) { const int d = curpos + 16 * g + 4 * fq + j - (qbase + 16 * qg); s[qg][0][g][j] = (d <= 128 && d >= -128) ? s[qg][0][g][j] : -1e30f; }
            } else {
                const int kr = curpos >> 6;
#pragma unroll
                for (int qg = 0; qg < 2; ++qg) {
                    const int qrow = qbase + 16 * qg, r = qrow >> 6, c = qrow & 63;
                    const int rs = min(max(r - 4, 0), 24), cs = min(max(c - 8, 0), 48);
                    const bool rowok = (kr >= rs) && (kr < rs + 8);
                    const volatile LAS float* bb = bias + ((kr - r + 7) * 31 - c + 15 + 4 * fq);
                    float bv[4][4];
#pragma unroll
                    for (int g = 0; g < 4; ++g)
#pragma unroll
                        for (int j = 0; j < 4; ++j) bv[g][j] = bb[16 * g + j];
                    const int lo = cs - 4 * fq, hi = cs + 16 - 4 * fq;
#pragma unroll
                    for (int g = 0; g < 4; ++g)
#pragma unroll
                        for (int j = 0; j < 4; ++j) { const bool ok = rowok && (16 * g + j >= lo) && (16 * g + j < hi);
                            s[qg][0][g][j] = ok ? s[qg][0][g][j] + bv[g][j] : -1e30f; }
                }
            }
        }
        bf16x8 p[2][NB][2];
#pragma unroll
        for (int qg = 0; qg < 2; ++qg)
#pragma unroll
            for (int br = 0; br < NB; ++br) {
                f32x4 (&t)[4] = s[qg][br];
                int im = max(max(max(__builtin_bit_cast(int, t[0][0]), __builtin_bit_cast(int, t[0][1])), max(__builtin_bit_cast(int, t[0][2]), __builtin_bit_cast(int, t[0][3]))),
                             max(max(__builtin_bit_cast(int, t[1][0]), __builtin_bit_cast(int, t[1][1])), max(__builtin_bit_cast(int, t[1][2]), __builtin_bit_cast(int, t[1][3]))));
                im = max(im, max(max(max(__builtin_bit_cast(int, t[2][0]), __builtin_bit_cast(int, t[2][1])), max(__builtin_bit_cast(int, t[2][2]), __builtin_bit_cast(int, t[2][3]))),
                                 max(max(__builtin_bit_cast(int, t[3][0]), __builtin_bit_cast(int, t[3][1])), max(__builtin_bit_cast(int, t[3][2]), __builtin_bit_cast(int, t[3][3])))));
                if (__any(im > 0x41000000   || m[qg][br] < -1e29f)) {
                    float mx = fmaxf(fmaxf(fmaxf(t[0][0], t[0][1]), fmaxf(t[0][2], t[0][3])), fmaxf(fmaxf(t[1][0], t[1][1]), fmaxf(t[1][2], t[1][3])));
                    mx = fmaxf(mx, fmaxf(fmaxf(fmaxf(t[2][0], t[2][1]), fmaxf(t[2][2], t[2][3])), fmaxf(fmaxf(t[3][0], t[3][1]), fmaxf(t[3][2], t[3][3]))));
                    mx = fmaxf(mx, __shfl_xor(mx, 16)); mx = fmaxf(mx, __shfl_xor(mx, 32));
                    const float mabs = mx + mf[qg][br];
                    const float mn = fmaxf(m[qg][br], mabs), alpha = __builtin_amdgcn_exp2f(m[qg][br] - mn), shift = mn - mf[qg][br];
                    m[qg][br] = mn; l[qg][br] = l[qg][br] * alpha;
#pragma unroll
                    for (int g = 0; g < 4; ++g) t[g] = t[g] - shift;
#pragma unroll
                    for (int dg = 0; dg < 4; ++dg) o[qg][br][dg] = o[qg][br][dg] * alpha;
                }
#pragma unroll
                for (int g = 0; g < 4; ++g)
#pragma unroll
                    for (int j = 0; j < 4; ++j) t[g][j] = __builtin_amdgcn_exp2f(t[g][j]);
                u32x4 p0u, p1u;
                p0u.x = pk2v(t[0][0], t[0][1]); p0u.y = pk2v(t[0][2], t[0][3]); p0u.z = pk2v(t[1][0], t[1][1]); p0u.w = pk2v(t[1][2], t[1][3]);
                p1u.x = pk2v(t[2][0], t[2][1]); p1u.y = pk2v(t[2][2], t[2][3]); p1u.z = pk2v(t[3][0], t[3][1]); p1u.w = pk2v(t[3][2], t[3][3]);
                p[qg][br][0] = __builtin_bit_cast(bf16x8, p0u); p[qg][br][1] = __builtin_bit_cast(bf16x8, p1u);
                l[qg][br] = MFMA16(ones, p[qg][br][0], l[qg][br]); l[qg][br] = MFMA16(ones, p[qg][br][1], l[qg][br]);
            }
        u32x2 vfr[4][4];
#pragma unroll
        for (int dg = 0; dg < 4; ++dg) { const LAS unsigned char* vrow = Vt + ((16 * dg + fr) * KSTR + 4 * fq) * 2;
            vfr[dg][0] = *(const LAS u32x2*)(vrow); vfr[dg][1] = *(const LAS u32x2*)(vrow + 32); vfr[dg][2] = *(const LAS u32x2*)(vrow + 64); vfr[dg][3] = *(const LAS u32x2*)(vrow + 96); }
        __builtin_amdgcn_sched_barrier(0);
#pragma unroll
        for (int dg = 0; dg < 4; ++dg) {
            const u32x2 a = vfr[dg][0], b = vfr[dg][1], cc = vfr[dg][2], d = vfr[dg][3];
            u32x4 v0; v0.x = a.x; v0.y = a.y; v0.z = b.x; v0.w = b.y;
            u32x4 v1; v1.x = cc.x; v1.y = cc.y; v1.z = d.x; v1.w = d.y;
            const bf16x8 va0 = __builtin_bit_cast(bf16x8, v0), va1 = __builtin_bit_cast(bf16x8, v1);
#pragma unroll
            for (int qg = 0; qg < 2; ++qg)
#pragma unroll
                for (int br = 0; br < NB; ++br) { o[qg][br][dg] = MFMA16(va0, p[qg][br][0], o[qg][br][dg]); o[qg][br][dg] = MFMA16(va1, p[qg][br][1], o[qg][br][dg]); }
        }
        if (more) { *(LAS u32x4*)(lds + (buf ^ 1) * ABUF_BYTES + stoff) = kA; *(LAS u32x4*)(lds + (buf ^ 1) * ABUF_BYTES + vst) = vA; }
        __syncthreads();
        }
        if (i2 + 1 >= ntiles) break;
        {   const int i = i2 + 1; const int buf = i & 1, curpos = TILEPOS(i); const bool more = (i + 1) < ntiles;
            { const int pos2 = (i + 2 < ntiles) ? TILEPOS(i + 2) : curpos;
              kA = *(const u32x4*)(Kp + (size_t)(pos2 + sr) * 64 + sc); vA = *(const u32x4*)(Vp + (size_t)pos2 * 64 + vgo); }
        const LAS unsigned char* Kt = lds + buf * ABUF_BYTES; const LAS unsigned char* Vt = Kt + 9216;
        float mf[2][NB]; f32x4 s[2][NB][4];
#pragma unroll
        for (int qg = 0; qg < 2; ++qg)
#pragma unroll
            for (int br = 0; br < NB; ++br) mf[qg][br] = (m[qg][br] < -1e29f) ? 0.f : m[qg][br];
        bf16x8 kfr[8];
#pragma unroll
        for (int g = 0; g < 4; ++g) { kfr[2 * g] = *(const LAS bf16x8*)(Kt + ((16 * g + fr) * KSTR + fq * 8) * 2); kfr[2 * g + 1] = *(const LAS bf16x8*)(Kt + ((16 * g + fr) * KSTR + 32 + fq * 8) * 2); }
        __builtin_amdgcn_sched_barrier(0);
#pragma unroll
        for (int g = 0; g < 4; ++g) {
            const bf16x8 k0 = kfr[2 * g], k1 = kfr[2 * g + 1];
#pragma unroll
            for (int qg = 0; qg < 2; ++qg) {
                const float c0 = -mf[qg][0];
                if (DIFF) { const float c1 = -mf[qg][NB - 1];
                    s[qg][0][g] = MFMA16(k0, qf[qg][0], ((f32x4){c0, c0, c0, c0})); s[qg][NB - 1][g] = MFMA16(k1, qf[qg][1], ((f32x4){c1, c1, c1, c1})); }
                else { s[qg][0][g] = MFMA16(k0, qf[qg][0], ((f32x4){c0, c0, c0, c0})); s[qg][0][g] = MFMA16(k1, qf[qg][1], s[qg][0][g]); }
            }
        }
        if (!DIFF && maskmode != 0 && i >= nfirst) {
            if (maskmode == 1) {
#pragma unroll
                for (int qg = 0; qg < 2; ++qg)
#pragma unroll
                    for (int g = 0; g < 4; ++g)
#pragma unroll
                        for (int j = 0; j < 4; ++j) { const int d = curpos + 16 * g + 4 * fq + j - (qbase + 16 * qg); s[qg][0][g][j] = (d <= 128 && d >= -128) ? s[qg][0][g][j] : -1e30f; }
            } else {
                const int kr = curpos >> 6;
#pragma unroll
                for (int qg = 0; qg < 2; ++qg) {
                    const int qrow = qbase + 16 * qg, r = qrow >> 6, c = qrow & 63;
                    const int rs = min(max(r - 4, 0), 24), cs = min(max(c - 8, 0), 48);
                    const bool rowok = (kr >= rs) && (kr < rs + 8);
                    const volatile LAS float* bb = bias + ((kr - r + 7) * 31 - c + 15 + 4 * fq);
                    float bv[4][4];
#pragma unroll
                    for (int g = 0; g < 4; ++g)
#pragma unroll
                        for (int j = 0; j < 4; ++j) bv[g][j] = bb[16 * g + j];
                    const int lo = cs - 4 * fq, hi = cs + 16 - 4 * fq;
#pragma unroll
                    for (int g = 0; g < 4; ++g)
#pragma unroll
                        for (int j = 0; j < 4; ++j) { const bool ok = rowok && (16 * g + j >= lo) && (16 * g + j < hi);
                            s[qg][0][g][j] = ok ? s[qg][0][g][j] + bv[g][j] : -1e30f; }
                }
            }
        }
        bf16x8 p[2][NB][2];
#pragma unroll
        for (int qg = 0; qg < 2; ++qg)
#pragma unroll
            for (int br = 0; br < NB; ++br) {
                f32x4 (&t)[4] = s[qg][br];
                int im = max(max(max(__builtin_bit_cast(int, t[0][0]), __builtin_bit_cast(int, t[0][1])), max(__builtin_bit_cast(int, t[0][2]), __builtin_bit_cast(int, t[0][3]))),
                             max(max(__builtin_bit_cast(int, t[1][0]), __builtin_bit_cast(int, t[1][1])), max(__builtin_bit_cast(int, t[1][2]), __builtin_bit_cast(int, t[1][3]))));
                im = max(im, max(max(max(__builtin_bit_cast(int, t[2][0]), __builtin_bit_cast(int, t[2][1])), max(__builtin_bit_cast(int, t[2][2]), __builtin_bit_cast(int, t[2][3]))),
                                 max(max(__builtin_bit_cast(int, t[3][0]), __builtin_bit_cast(int, t[3][1])), max(__builtin_bit_cast(int, t[3][2]), __builtin_bit_cast(int, t[3][3])))));
                if (__any(im > 0x41000000   || m[qg][br] < -1e29f)) {
                    float mx = fmaxf(fmaxf(fmaxf(t[0][0], t[0][1]), fmaxf(t[0][2], t[0][3])), fmaxf(fmaxf(t[1][0], t[1][1]), fmaxf(t[1][2], t[1][3])));
                    mx = fmaxf(mx, fmaxf(fmaxf(fmaxf(t[2][0], t[2][1]), fmaxf(t[2][2], t[2][3])), fmaxf(fmaxf(t[3][0], t[3][1]), fmaxf(t[3][2], t[3][3]))));
                    mx = fmaxf(mx, __shfl_xor(mx, 16)); mx = fmaxf(mx, __shfl_xor(mx, 32));
                    const float mabs = mx + mf[qg][br];
                    const float mn = fmaxf(m[qg][br], mabs), alpha = __builtin_amdgcn_exp2f(m[qg][br] - mn), shift = mn - mf[qg][br];
                    m[qg][br] = mn; l[qg][br] = l[qg][br] * alpha;
#pragma unroll
                    for (int g = 0; g < 4; ++g) t[g] = t[g] - shift;
#pragma unroll
                    for (int dg = 0; dg < 4; ++dg) o[qg][br][dg] = o[qg][br][dg] * alpha;
                }
#pragma unroll
                for (int g = 0; g < 4; ++g)
#pragma unroll
                    for (int j = 0; j < 4; ++j) t[g][j] = __builtin_amdgcn_exp2f(t[g][j]);
                u32x4 p0u, p1u;
                p0u.x = pk2v(t[0][0], t[0][1]); p0u.y = pk2v(t[0][2], t[0][3]); p0u.z = pk2v(t[1][0], t[1][1]); p0u.w = pk2v(t[1][2], t[1][3]);
                p1u.x = pk2v(t[2][0], t[2][1]); p1u.y = pk2v(t[2][2], t[2][3]); p1u.z = pk2v(t[3][0], t[3][1]); p1u.w = pk2v(t[3][2], t[3][3]);
                p[qg][br][0] = __builtin_bit_cast(bf16x8, p0u); p[qg][br][1] = __builtin_bit_cast(bf16x8, p1u);
                l[qg][br] = MFMA16(ones, p[qg][br][0], l[qg][br]); l[qg][br] = MFMA16(ones, p[qg][br][1], l[qg][br]);
            }
        u32x2 vfr[4][4];
#pragma unroll
        for (int dg = 0; dg < 4; ++dg) { const LAS unsigned char* vrow = Vt + ((16 * dg + fr) * KSTR + 4 * fq) * 2;
            vfr[dg][0] = *(const LAS u32x2*)(vrow); vfr[dg][1] = *(const LAS u32x2*)(vrow + 32); vfr[dg][2] = *(const LAS u32x2*)(vrow + 64); vfr[dg][3] = *(const LAS u32x2*)(vrow + 96); }
        __builtin_amdgcn_sched_barrier(0);
#pragma unroll
        for (int dg = 0; dg < 4; ++dg) {
            const u32x2 a = vfr[dg][0], b = vfr[dg][1], cc = vfr[dg][2], d = vfr[dg][3];
            u32x4 v0; v0.x = a.x; v0.y = a.y; v0.z = b.x; v0.w = b.y;
            u32x4 v1; v1.x = cc.x; v1.y = cc.y; v1.z = d.x; v1.w = d.y;
            const bf16x8 va0 = __builtin_bit_cast(bf16x8, v0), va1 = __builtin_bit_cast(bf16x8, v1);
#pragma unroll
            for (int qg = 0; qg < 2; ++qg)
#pragma unroll
                for (int br = 0; br < NB; ++br) { o[qg][br][dg] = MFMA16(va0, p[qg][br][0], o[qg][br][dg]); o[qg][br][dg] = MFMA16(va1, p[qg][br][1], o[qg][br][dg]); }
        }
        if (more) { *(LAS u32x4*)(lds + (buf ^ 1) * ABUF_BYTES + stoff) = kB; *(LAS u32x4*)(lds + (buf ^ 1) * ABUF_BYTES + vst) = vB; }
        __syncthreads();
        }
    }
#undef TILEPOS
#pragma unroll
    for (int qg = 0; qg < 2; ++qg) {
        const float inv1 = 1.0f / l[qg][0][0];
        bf16_t* yr = Yp + (size_t)(wave * 32 + qg * 16 + fr) * 1024 + 4 * fq;
        if (DIFF) {
            const float inv2 = lam / l[qg][NB - 1][0];
            f32x4 y[4]; float ss = 0.f;
#pragma unroll
            for (int dg = 0; dg < 4; ++dg) { y[dg] = o[qg][0][dg] * inv1 - o[qg][NB - 1][dg] * inv2; ss += (y[dg][0] * y[dg][0] + y[dg][1] * y[dg][1]) + (y[dg][2] * y[dg][2] + y[dg][3] * y[dg][3]); }
            ss += __shfl_xor(ss, 16); ss += __shfl_xor(ss, 32);
            const float rr = oscale / sqrtf(ss * (1.0f / 64.0f) + 1e-6f);
#pragma unroll
            for (int dg = 0; dg < 4; ++dg) { const f32x4 gv = *(const f32x4*)(subg + 16 * dg + 4 * fq); const f32x4 yy = y[dg] * rr * gv;
                *(unsigned long long*)(yr + 16 * dg) = (unsigned long long)pk2(yy[0], yy[1]) | ((unsigned long long)pk2(yy[2], yy[3]) << 32); }
        } else {
#pragma unroll
            for (int dg = 0; dg < 4; ++dg) { const f32x4 yy = o[qg][0][dg] * inv1;
                *(unsigned long long*)(yr + 16 * dg) = (unsigned long long)pk2(yy[0], yy[1]) | ((unsigned long long)pk2(yy[2], yy[3]) << 32); }
        }
    }
}

__device__ __forceinline__ void attn_phase(LAS unsigned char* lds, unsigned* counter, bool with_ctx, const bf16_t* Qb, const bf16_t* Kb, const bf16_t* Vtb, bf16_t* Y,
                                           const float* sink, const float* relb, const float* subg, float lam, float oscale, int tid, int lane, int wave) {
    const int nunits = with_ctx ? 1152 : 1024;
    LAS float* bias = (LAS float*)(lds + ATT_BIAS_OFF);
    LAS int* cur = (LAS int*)(lds + ATT_CUR_OFF);
    for (;;) {
        if (tid == 0) *cur = (int)atomicAdd(counter, 1u);
        __syncthreads();
        const int u = *cur;
        __syncthreads();
        if (u >= nunits) break;
        int mo, b, h, q0;
        if (u < 1024) { mo = u >> 8; const int i = u & 255; b = i >> 5; h = (i >> 3) & 3; q0 = (i & 7) * 256; }
        else { const int v = u - 1024; mo = v >> 5; const int i = v & 31; b = i >> 2; h = i & 3; q0 = 2048; }
        const int mixer = mo == 0 ? 3 : (mo == 1 ? 1 : (mo == 2 ? 2 : 0));
        const int kvh = (mixer < 2) ? (h >> 1) : h;
        const int kvbase = mixer == 0 ? 0 : (mixer == 1 ? 2 : (mixer == 2 ? 4 : 8));
        const bf16_t* Qp = Qb + (size_t)((mixer * 8 + b) * 4 + h) * POS * 64;
        const bf16_t* Kp = Kb + (size_t)((kvbase + kvh) * 8 + b) * POS * 64;
        const bf16_t* Vp = Vtb + (size_t)((kvbase + kvh) * 8 + b) * POS * 64;
        const bool isctx = q0 >= 2048;
        const int yrow0 = isctx ? ML + b * 256 : b * 2048 + q0;
        bf16_t* Yp = Y + (size_t)yrow0 * 1024 + mixer * 256 + h * 64;
        int ntiles, nfirst, firstpos, secondpos = 0, maskmode = 0;
        if (isctx) { ntiles = 4; nfirst = 4; firstpos = 2048; }
        else if (mixer == 1 || mixer == 3) { ntiles = 36; nfirst = 36; firstpos = 0; }
        else if (mixer == 0) { const int lo = max(0, q0 - 128), hi = min(2048, q0 + 384); nfirst = 4; firstpos = 2048; secondpos = lo; ntiles = 4 + (hi - lo) / 64; maskmode = 1; }
        else { const int r0 = q0 >> 6; const int rs0 = min(max(r0 - 4, 0), 24), rs3 = min(max(r0 - 1, 0), 24); nfirst = 4; firstpos = 2048; secondpos = rs0 * 64; ntiles = 4 + (rs3 + 8 - rs0); maskmode = 2;
            for (int i = tid; i < 465; i += NT) bias[i] = relb[h * 465 + i] * LOG2E; }
        float m_init = -1e30f; bool sinkf = false;
        if (mixer == 0) { m_init = sink[h] * LOG2E; sinkf = true; }
        if (mixer == 3) attn_unit<true>(lds, Qp, Kp, Vp, Yp, q0, ntiles, nfirst, firstpos, secondpos, 0, -1e30f, false, bias, lam, subg, oscale, wave);
        else attn_unit<false>(lds, Qp, Kp, Vp, Yp, q0, ntiles, nfirst, firstpos, secondpos, maskmode, m_init, sinkf, bias, 0.f, subg, 1.f, wave);
    }
}

struct Args { const float* in[24]; float* out; unsigned char* ws; };
#define CAS __attribute__((address_space(4)))
__device__ __forceinline__ const CAS char* kargs() { const CAS char* p = (const CAS char*)__builtin_amdgcn_kernarg_segment_ptr(); asm volatile("" : "+s"(p)); return p; }
__device__ __forceinline__ const float* ldin(int i) { return *(const float* const CAS*)(kargs() + 8 * i); }
__device__ __forceinline__ float* ldout() { return *(float* const CAS*)(kargs() + 192); }
__device__ __forceinline__ unsigned char* ldws() { return *(unsigned char* const CAS*)(kargs() + 200); }
__global__ void __launch_bounds__(NT, 2) fwd_kernel(Args a) {
    extern __shared__ __attribute__((aligned(16))) unsigned char lds_raw[];
    LAS unsigned char* lds = (LAS unsigned char*)lds_raw;
    cg::grid_group grid = cg::this_grid();
#define TID (tid_now())
#define LANE (TID & 63)
#define WAVE (__builtin_amdgcn_readfirstlane(TID >> 6))
#define GRD (grd_now())
#define BID (bid_now())
#define GW (BID * 8 + WAVE)
#define NGW (GRD * 8)
#define WSF(off) ((float*)(ldws() + (off)))
#define WSB(off) ((bf16_t*)(ldws() + (off)))

    if (grd_now() == 0x7fffffff) grid.sync();
    if (tid_now() < 16) ((LAS unsigned*)(lds + MISC_OFF))[tid_now()] = 0u;
    __syncthreads();
    (void)xcd_barrier_post((unsigned*)(ldws() + WS_BAR), (volatile LAS unsigned*)(lds + MISC_OFF));
    if (BID == GRD - 1) p0_misc(WSF(WS_ROPE), WSF(WS_SCAL), ldin(15), ldin(16), ldin(17), ldin(18), TID);
#pragma unroll 1
    for (int rep = 0; rep < REP_LIGHT; ++rep)
    p0_mod(lds, ldin(1), ldin(3), ldin(4), ldin(5), WSF(WS_MOD), BID, GRD, TID);
    GSYNC();

#define FUSE (GRD == 256)
#define MODL(ll) (WSF(WS_MOD) + (size_t)(ll) * 9 * 9216)
#define CNT(inst) ((unsigned*)(ldws() + WS_CNT) + (inst) * 64 * 16)
#pragma unroll 1
    for (int it = 0; it < 4; ++it) {
        const int l = it >> 1, f = it & 1;
        const bool lat_only = (l == 1 && f == 1);
        if (f == 0) convert_layer(lds, l, ldin(6), ldin(7), ldin(8), ldin(9), ldin(10), ldin(20), ldin(21), ldin(22), ldws() + WS_W, GW, NGW, WAVE, LANE);
        if (it == 0) norm_mod_phase(ldin(0), ldin(2), nullptr, nullptr, nullptr, WSF(WS_XC), WSB(WS_H), MODL(0), 0, 0, MT, GW, NGW, LANE);
        else if (!FUSE) norm_mod_phase(ldout(), WSF(WS_XC), nullptr, nullptr, (it == 1 || it == 2) ? SPLIT_PART : nullptr, WSF(WS_XC), WSB(WS_H), MODL(l), f ? 6 : 0, 0, lat_only ? ML : MT, GW, NGW, LANE);
        else if (!lat_only) norm_mod_phase(ldout(), WSF(WS_XC), nullptr, nullptr, SPLIT_PART, WSF(WS_XC), WSB(WS_H), MODL(l), f ? 6 : 0, ML, MT, GW, NGW, LANE);
        if (!(FUSE && lat_only)) GSYNC();
        {
            const int M = lat_only ? ML : MT;
            pg8::Gemm g{WSB(WS_H), (const bf16_t*)(ldws() + WS_W + (f ? W_GU2 : W_GU1)), M, 2 * DFF, DM}; pg8::StaticOrder S; S.init(M, 2 * DFF, GRD, BID, DM);
            pg8::EpiSwiglu E{WSB(WS_G), DFF};
            pg8::gemm_phase<pg8::EpiSwiglu, pg8::StaticOrder, true, true>(lds, g, S, E);
        }
        GSYNC();
        {
            const int M = lat_only ? ML : MT;
            pg8::Gemm g{WSB(WS_G), (const bf16_t*)(ldws() + WS_W + (f ? W_D2 : W_D1)), M, DM, DFF}; pg8::SplitOrder S; S.init(M, DM, GRD, BID, DFF);
            const float* nsh = (f == 0) ? MODL(l) + 3 * 1024 : ((it == 1) ? MODL(1) : ldin(23));
            pg8::EpiRes E{ldout(), WSF(WS_XC), MODL(l) + (f ? 8 : 2) * 1024, 0.5f, DFF / 64, WSF(WS_Q), (it == 0) ? ldin(0) : (const float*)ldout(), (it == 0) ? ldin(2) : (const float*)WSF(WS_XC), FUSE ? 1 : 0, (it == 3) ? 1 : 0, WSB(WS_H), nsh, WSF(WS_SLOTS), CNT(it)};
            pg8::gemm_phase<pg8::EpiRes, pg8::SplitOrder, true, true>(lds, g, S, E);
        }
        if (it < 3) GSYNC();
        if (f == 0) {
            if (!FUSE) norm_mod_phase(ldout(), (it == 0 && SPLIT_PART) ? ldin(2) : (const float*)WSF(WS_XC), nullptr, nullptr, SPLIT_PART, WSF(WS_XC), WSB(WS_H), MODL(l), 3, 0, MT, GW, NGW, LANE);
            else norm_mod_phase(ldout(), (it == 0) ? ldin(2) : (const float*)WSF(WS_XC), nullptr, nullptr, SPLIT_PART, WSF(WS_XC), WSB(WS_H), MODL(l), 3, ML, MT, GW, NGW, LANE);
            GSYNC();
            {
                pg8::Gemm g{WSB(WS_H), (const bf16_t*)(ldws() + WS_W + W_IN), MT, INW, DM}; pg8::StaticOrder S; S.init(MT, INW, GRD, BID, DM);
                pg8::EpiQKV E{WSB(WS_Q), WSB(WS_K), WSB(WS_VT), WSF(WS_ROPE), ldin(12) + l * 64, ldin(13) + l * 64, lds + 131072};
#pragma unroll 1
                for (int rep = 0; rep < REP_GU; ++rep)
                pg8::gemm_phase<pg8::EpiQKV, pg8::StaticOrder, true, true>(lds, g, S, E);
            }
            GSYNC();
            {
                const float lam = __hip_atomic_load(WSF(WS_SCAL) + l, __ATOMIC_RELAXED, __HIP_MEMORY_SCOPE_AGENT); const float lam_init = 0.8f - 0.6f * expf(-0.3f * (float)l);
#pragma unroll 1
                for (int rep = 0; rep < REP_ATT; ++rep)
                attn_phase(lds, (unsigned*)(ldws() + WS_CTL) + 64 * l + 16 * rep, l == 0, WSB(WS_Q), WSB(WS_K), WSB(WS_VT), WSB(WS_H), ldin(11) + l * 4, ldin(14) + l * 4 * 465, ldin(19) + l * 64, lam, 1.0f - lam_init, TID, LANE, WAVE);
            }
            GSYNC();
            {
                const int M = (l == 1) ? ML : MT;
                pg8::Gemm g{WSB(WS_H), (const bf16_t*)(ldws() + WS_W + W_OUT), M, DM, DM}; pg8::SplitOrder S; S.init(M, DM, GRD, BID, DM);
                pg8::EpiRes E{ldout(), WSF(WS_XC), MODL(l) + 5 * 1024, 1.0f, DM / 64, WSF(WS_Q), (const float*)ldout(), (const float*)WSF(WS_XC), FUSE ? 1 : 0, 0, WSB(WS_H), MODL(l) + 6 * 1024, WSF(WS_SLOTS), CNT(4 + l)};
                pg8::gemm_phase<pg8::EpiRes, pg8::SplitOrder, true, true>(lds, g, S, E);
            }
            GSYNC();
        }
    }
    if (!FUSE) { GSYNC(); final_norm_phase(ldout(), ldin(23), GW, NGW, LANE); }

}

extern "C" void kernel_launch(void* const* d_in, const int* in_sizes, int n_in, void* d_out, int out_size, void* d_ws, size_t ws_size, hipStream_t stream) {
    static int grid = 0;
    if (grid == 0) {
        if (n_in != 24 || out_size != ML * DM || ws_size < WS_END) { fprintf(stderr, "kernel_launch: unexpected shapes (n_in %d out %d ws %zu)\n", n_in, out_size, ws_size); grid = -1; return; }
        int dev = 0, cus = 0, per_cu = 0;
        (void)hipGetDevice(&dev);
        (void)hipDeviceGetAttribute(&cus, hipDeviceAttributeMultiprocessorCount, dev);
        (void)hipFuncSetAttribute((const void*)fwd_kernel, hipFuncAttributeMaxDynamicSharedMemorySize, LDS_BYTES);
        if (hipOccupancyMaxActiveBlocksPerMultiprocessor(&per_cu, (const void*)fwd_kernel, NT, LDS_BYTES) != hipSuccess || per_cu < 1) per_cu = 1;
        (void)hipGetLastError();
        grid = cus * 1;
    }
    if (grid < 0) return;
    (void)hipMemsetAsync((char*)d_ws + WS_CTL, 0, CTL_ZERO_BYTES, stream);
    Args a{};
    for (int i = 0; i < 24; ++i) a.in[i] = (const float*)d_in[i];
    a.out = (float*)d_out; a.ws = (unsigned char*)d_ws;
    void* args[] = {&a};
    hipError_t e = hipLaunchCooperativeKernel((const void*)fwd_kernel, dim3(grid), dim3(NT), args, LDS_BYTES, stream);
    if (e != hipSuccess) fprintf(stderr, "cooperative launch failed: %s (grid %d)\n", hipGetErrorString(e), grid);
}
```

```cpp
#include <hip/hip_runtime.h>
#include <hip/hip_cooperative_groups.h>
#include <cstdio>
#include <cstdint>
namespace cg = cooperative_groups;
__device__ __forceinline__ int tid_now() { int t = (int)threadIdx.x; asm volatile("" : "+v"(t)); return t; }
__device__ __forceinline__ int bid_now() { int t = (int)blockIdx.x; asm volatile("" : "+s"(t)); return t; }
__device__ __forceinline__ int grd_now() { int t = (int)gridDim.x; asm volatile("" : "+s"(t)); return t; }
namespace pg8 {
#define PG8_LAS __attribute__((address_space(3)))
typedef unsigned short bf16_t;
typedef short bf16x8 __attribute__((ext_vector_type(8)));
typedef float f32x4 __attribute__((ext_vector_type(4)));
typedef unsigned u32x4 __attribute__((ext_vector_type(4)));
constexpr int BM = 256, BK = 64, HALF = 128, HTB = HALF * BK * 2  , STAGE_BYTES = 8 * HTB, NXCD = 8, WGM = 8;

__host__ __device__ __forceinline__ int lds_byte(int r, int c) { const int st = (r >> 4) * 2 + (c >> 5), rr = r & 15, cc = c & 31, ob = rr * 64 + cc * 2; return st * 1024 + (ob ^ (((ob >> 9) & 1) << 5)); }
__host__ __device__ __forceinline__ void stage_rc(int b, int& R, int& C) { const int st = b / 1024, sb = b % 1024, swz = sb ^ (((sb >> 9) & 1) << 5); R = (st >> 1) * 16 + swz / 64; C = (st & 1) * 32 + (swz % 64) / 2; }
__host__ __device__ __forceinline__ int perm32(int rho) { const int n = rho >> 4, i = rho & 15; return 8 * (i >> 2) + 4 * n + (i & 3); }

struct Unit { int pm, pn, k0, nk, pt; };
struct Gemm { const bf16_t* A; const bf16_t* Bt; int M, N, K; };

struct StaticOrder {
    int nM, nN, nwg, G, c, nK;
    __host__ __device__ void init(int M, int N, int G_, int c_, int K_) { nM = M / BM; nN = N / BM; nwg = nM * nN; G = G_; c = c_; nK = K_ / BK; }
    __host__ __device__ bool next(int i, Unit& u) const {
        const long L = (long)i * G + c; if (L >= nwg) return false;
        int wgid = (int)L; { const int q = nwg / NXCD, r = nwg % NXCD, xcd = wgid % NXCD, off = wgid / NXCD; wgid = (xcd < r ? xcd * (q + 1) : r * (q + 1) + (xcd - r) * q) + off; }
        const int nig = WGM * nN, gid = wgid / nig, fm = gid * WGM, gsz = (nM - fm) < WGM ? (nM - fm) : WGM;
        u.pm = fm + ((wgid % nig) % gsz); u.pn = (wgid % nig) / gsz; u.k0 = 0; u.nk = nK; u.pt = 0; return true;
    }
    __device__ __forceinline__ void a_ready(const Unit&) const {}
    __device__ __forceinline__ void done(const Unit&) const {}
};
typedef __bf16 bf16x2c_t __attribute__((ext_vector_type(2)));
typedef float f32x2c_t __attribute__((ext_vector_type(2)));
__device__ __forceinline__ unsigned cvt_pk_bf16(float lo, float hi) { f32x2c_t v = {lo, hi}; bf16x2c_t r = __builtin_convertvector(v, bf16x2c_t); return __builtin_bit_cast(unsigned, r); }
typedef float f32x2 __attribute__((ext_vector_type(2)));
template <class Epi, class Sched, bool ALIGN_EPI = false, bool SP2 = false>
__device__ __forceinline__ void gemm_phase(PG8_LAS unsigned char* lds, const Gemm g, const Sched& S, const Epi& E) {
    const int tid = tid_now(), wid = __builtin_amdgcn_readfirstlane(tid >> 6), lane = tid & 63, wr = wid >> 2, wc = wid & 3, fr = lane & 15, fq = lane >> 4;
    const int K = g.K;
    unsigned voffA[2], voffB[2];
#pragma unroll
    for (int i = 0; i < 2; ++i) { int R, C; stage_rc(tid * 16 + i * 8192, R, C); const int Rb = Epi::PERM ? ((R & ~31) + perm32(R & 31)) : R;
        voffA[i] = (unsigned)(R * K + C) * 2u; voffB[i] = (unsigned)(Rb * K + C) * 2u; }
    const size_t kstep = (size_t)(BK * 2);
    const size_t hstep = (size_t)HALF * K * 2;
    const size_t tstep = 2 * hstep;
    const unsigned ldsw = (unsigned)wid * 1024u;
    const int aoff = lds_byte(wr * 64 + fr, fq * 8), boff = lds_byte(wc * 32 + fr, fq * 8);
#define PG8_SA(b, h) (((b) * 2 + (h)) * HTB)
#define PG8_SB(b, h) ((4 + (b) * 2 + (h)) * HTB)
#define PG8_STAGE(bufoff, gbase, voff) do { _Pragma("unroll") for (int _i = 0; _i < 2; ++_i) \
        __builtin_amdgcn_global_load_lds((const unsigned*)((const char*)(gbase) + (voff)[_i]), (PG8_LAS unsigned*)(lds + (bufoff) + ldsw + _i * 8192), 16, 0, 0); } while (0)
#define PG8_LDA(dst, b, h) do { _Pragma("unroll") for (int m = 0; m < 4; ++m) _Pragma("unroll") for (int k = 0; k < 2; ++k) dst[m][k] = *(const PG8_LAS bf16x8*)(lds + PG8_SA(b, h) + aoff + m * 2048 + k * 1024); } while (0)
#define PG8_LDB(dst, b, h) do { _Pragma("unroll") for (int n = 0; n < 2; ++n) _Pragma("unroll") for (int k = 0; k < 2; ++k) dst[n][k] = *(const PG8_LAS bf16x8*)(lds + PG8_SB(b, h) + boff + n * 2048 + k * 1024); } while (0)
#define PG8_MMA(ai, bj, At, Bt) do { __builtin_amdgcn_s_setprio(1); _Pragma("unroll") for (int m = 0; m < 4; ++m) _Pragma("unroll") for (int n = 0; n < 2; ++n) _Pragma("unroll") for (int k = 0; k < 2; ++k) \
        acc[ai][bj][m][n] = __builtin_amdgcn_mfma_f32_16x16x32_bf16(Bt[n][k], At[m][k], acc[ai][bj][m][n], 0, 0, 0); __builtin_amdgcn_s_setprio(0); } while (0)
#define PG8_WAIT_V(n) asm volatile("s_waitcnt vmcnt(" #n ")" ::: "memory")
#define PG8_WAIT_L(n) asm volatile("s_waitcnt lgkmcnt(" #n ")" ::: "memory")
#define PG8_BAR __builtin_amdgcn_s_barrier()
#define PG8_SCHED __builtin_amdgcn_sched_barrier(0)
    Unit cur, nxt; int ui = 0;
    if (!S.next(0, cur)) return;
    f32x4 acc[2][2][4][2];
#pragma unroll
    for (int a = 0; a < 2; ++a)
#pragma unroll
        for (int b = 0; b < 2; ++b)
#pragma unroll
            for (int m = 0; m < 4; ++m)
#pragma unroll
                for (int n = 0; n < 2; ++n) acc[a][b][m][n] = (f32x4){0.f, 0.f, 0.f, 0.f};
    bf16x8 At[4][2], B0[2][2], B1[2][2];
    const char* cA = (const char*)g.A + (size_t)cur.pm * tstep + (size_t)cur.k0 * kstep; const char* cB = (const char*)g.Bt + (size_t)cur.pn * tstep + (size_t)cur.k0 * kstep;
    S.a_ready(cur);
    if constexpr (SP2) {
        PG8_STAGE(PG8_SB(0, 0), cB, voffB); PG8_STAGE(PG8_SB(0, 1), cB + hstep, voffB); PG8_STAGE(PG8_SA(0, 0), cA, voffA); PG8_STAGE(PG8_SA(0, 1), cA + hstep, voffA);
        if (wr == 1) PG8_BAR;
        PG8_WAIT_V(2); PG8_BAR;
        PG8_STAGE(PG8_SB(1, 0), cB + kstep, voffB); PG8_STAGE(PG8_SA(1, 0), cA + kstep, voffA); PG8_STAGE(PG8_SB(1, 1), cB + hstep + kstep, voffB);
        PG8_WAIT_V(6); PG8_BAR;
    } else {
        PG8_STAGE(PG8_SB(0, 0), cB, voffB); PG8_STAGE(PG8_SA(0, 0), cA, voffA); PG8_STAGE(PG8_SB(0, 1), cB + hstep, voffB); PG8_STAGE(PG8_SA(0, 1), cA + hstep, voffA);
        if (wr == 1) PG8_BAR;
        PG8_WAIT_V(4); PG8_BAR;
        PG8_STAGE(PG8_SB(1, 0), cB + kstep, voffB); PG8_STAGE(PG8_SA(1, 0), cA + kstep, voffA); PG8_STAGE(PG8_SB(1, 1), cB + hstep + kstep, voffB);
        PG8_WAIT_V(6); PG8_BAR;
    }
    for (;;) {
        const bool has_next = S.next(ui + 1, nxt);
        const char* nA = has_next ? (const char*)g.A + (size_t)nxt.pm * tstep + (size_t)nxt.k0 * kstep : cA; const char* nB = has_next ? (const char*)g.Bt + (size_t)nxt.pn * tstep + (size_t)nxt.k0 * kstep : cB;
        const int nt = cur.nk;
        for (int t = 0; t < nt; t += 2) {
            const bool last = (t == nt - 2);
            const char* a1 = cA + (size_t)(t + 1) * kstep;
            const char* a2 = last ? nA : cA + (size_t)(t + 2) * kstep; const char* b2 = last ? nB : cB + (size_t)(t + 2) * kstep;
            const char* a3 = a2 + kstep; const char* b3 = b2 + kstep;
            if (last && has_next) S.a_ready(nxt);
            if constexpr (SP2) {
            PG8_LDB(B0, 0, 0); PG8_LDB(B1, 0, 1); PG8_SCHED; PG8_LDA(At, 0, 0); PG8_STAGE(PG8_SA(1, 1), a1 + hstep, voffA);
            PG8_WAIT_V(8); PG8_WAIT_L(0); PG8_BAR; PG8_MMA(0, 0, At, B0); PG8_MMA(0, 1, At, B1); PG8_BAR; PG8_SCHED;
            PG8_LDA(At, 0, 1); PG8_STAGE(PG8_SB(0, 0), b2, voffB); PG8_STAGE(PG8_SB(0, 1), b2 + hstep, voffB); PG8_STAGE(PG8_SA(0, 0), a2, voffA);
            PG8_WAIT_V(8); PG8_WAIT_L(0); PG8_BAR; PG8_MMA(1, 0, At, B0); PG8_MMA(1, 1, At, B1); PG8_BAR; PG8_SCHED;
            PG8_LDB(B0, 1, 0); PG8_LDB(B1, 1, 1); PG8_SCHED; PG8_LDA(At, 1, 0); PG8_STAGE(PG8_SA(0, 1), a2 + hstep, voffA);
            PG8_WAIT_V(8); PG8_WAIT_L(0); PG8_BAR; PG8_MMA(0, 0, At, B0); PG8_MMA(0, 1, At, B1); PG8_BAR; PG8_SCHED;
            PG8_LDA(At, 1, 1); PG8_STAGE(PG8_SB(1, 0), b3, voffB); PG8_STAGE(PG8_SB(1, 1), b3 + hstep, voffB); PG8_STAGE(PG8_SA(1, 0), a3, voffA);
            PG8_WAIT_V(8); PG8_WAIT_L(0); PG8_BAR; PG8_MMA(1, 0, At, B0); PG8_MMA(1, 1, At, B1); PG8_BAR; PG8_SCHED;
            } else {
            PG8_LDB(B0, 0, 0); PG8_SCHED; PG8_LDA(At, 0, 0); PG8_STAGE(PG8_SA(1, 1), a1 + hstep, voffA);
            PG8_WAIT_L(8); PG8_BAR; PG8_WAIT_L(0); PG8_MMA(0, 0, At, B0); PG8_BAR; PG8_SCHED;
            PG8_LDB(B1, 0, 1); PG8_STAGE(PG8_SB(0, 0), b2, voffB);
            PG8_BAR; PG8_WAIT_L(0); PG8_MMA(0, 1, At, B1); PG8_BAR;
            PG8_LDA(At, 0, 1); PG8_STAGE(PG8_SA(0, 0), a2, voffA);
            PG8_BAR; PG8_WAIT_L(0); PG8_MMA(1, 0, At, B0); PG8_BAR; PG8_SCHED;
            PG8_STAGE(PG8_SB(0, 1), b2 + hstep, voffB);
            PG8_WAIT_V(6); PG8_BAR; PG8_MMA(1, 1, At, B1); PG8_BAR;
            PG8_LDB(B0, 1, 0); PG8_SCHED; PG8_LDA(At, 1, 0); PG8_STAGE(PG8_SA(0, 1), a2 + hstep, voffA);
            PG8_WAIT_L(8); PG8_BAR; PG8_WAIT_L(0); PG8_MMA(0, 0, At, B0); PG8_BAR; PG8_SCHED;
            PG8_LDB(B1, 1, 1); PG8_STAGE(PG8_SB(1, 0), b3, voffB);
            PG8_BAR; PG8_WAIT_L(0); PG8_MMA(0, 1, At, B1); PG8_BAR;
            PG8_LDA(At, 1, 1); PG8_STAGE(PG8_SA(1, 0), a3, voffA);
            PG8_BAR; PG8_WAIT_L(0); PG8_MMA(1, 0, At, B0); PG8_BAR; PG8_SCHED;
            PG8_STAGE(PG8_SB(1, 1), b3 + hstep, voffB);
            PG8_WAIT_V(6); PG8_BAR; PG8_MMA(1, 1, At, B1); PG8_BAR;
            }
        }
        if constexpr (ALIGN_EPI) { if (wr == 0) PG8_BAR; }
        if constexpr (!Epi::AFTER_DRAIN) { E(acc, cur, wr, wc, fr, fq); S.done(cur); }
        else { if (has_next) E(acc, cur, wr, wc, fr, fq); }
        if (!has_next) break;
#pragma unroll
        for (int a = 0; a < 2; ++a)
#pragma unroll
            for (int b = 0; b < 2; ++b)
#pragma unroll
                for (int m = 0; m < 4; ++m)
#pragma unroll
                    for (int n = 0; n < 2; ++n) acc[a][b][m][n] = (f32x4){0.f, 0.f, 0.f, 0.f};
        cur = nxt; cA = nA; cB = nB; ++ui;
        if constexpr (ALIGN_EPI) { if (wr == 1) PG8_BAR; }
    }
    PG8_WAIT_V(0);
    if constexpr (!ALIGN_EPI) { if (wr == 0) PG8_BAR; }
    PG8_BAR;
    if constexpr (Epi::AFTER_DRAIN) { E.fused(acc, cur, wr, wc, fr, fq, lds, wid, lane); S.done(cur); }
#undef PG8_SA
#undef PG8_SB
#undef PG8_STAGE
#undef PG8_LDA
#undef PG8_LDB
#undef PG8_MMA
#undef PG8_WAIT_V
#undef PG8_WAIT_L
#undef PG8_BAR
#undef PG8_SCHED
}
}

namespace pg8 {
__device__ __forceinline__ float silu_f(float x) { return x * __builtin_amdgcn_rcpf(1.0f + __builtin_amdgcn_exp2f(-1.44269504f * x)); }

struct EpiPlain {
    static constexpr bool PERM = true, AFTER_DRAIN = false;
    bf16_t* O; int ldc;
    __device__ __forceinline__ void operator()(const f32x4 (&acc)[2][2][4][2], const Unit& u, int wr, int wc, int fr, int fq) const {
        const int row0 = u.pm * BM + wr * 64 + fr, col0 = u.pn * BM + wc * 32 + 8 * fq;
#pragma unroll
        for (int ai = 0; ai < 2; ++ai)
#pragma unroll
            for (int m = 0; m < 4; ++m) { bf16_t* rowp = O + (size_t)(row0 + ai * HALF + m * 16) * ldc + col0;
#pragma unroll
                for (int bj = 0; bj < 2; ++bj) { const f32x4 v0 = acc[ai][bj][m][0], v1 = acc[ai][bj][m][1]; u32x4 w;
                    w.x = cvt_pk_bf16(v0[0], v0[1]); w.y = cvt_pk_bf16(v0[2], v0[3]); w.z = cvt_pk_bf16(v1[0], v1[1]); w.w = cvt_pk_bf16(v1[2], v1[3]);
                    *(u32x4*)(rowp + bj * HALF) = w; } }
    }
};
struct EpiSwiglu {
    static constexpr bool PERM = true, AFTER_DRAIN = false;
    bf16_t* O; int ldc;
    __device__ __forceinline__ void operator()(const f32x4 (&acc)[2][2][4][2], const Unit& u, int wr, int wc, int fr, int fq) const {
        const int row0 = u.pm * BM + wr * 64 + fr, col0 = u.pn * HALF + wc * 32 + 8 * fq;
#pragma unroll
        for (int ai = 0; ai < 2; ++ai)
#pragma unroll
            for (int m = 0; m < 4; ++m) { bf16_t* rowp = O + (size_t)(row0 + ai * HALF + m * 16) * ldc + col0;
                const f32x4 g0 = acc[ai][0][m][0], g1 = acc[ai][0][m][1], u0 = acc[ai][1][m][0], u1 = acc[ai][1][m][1]; u32x4 w;
                w.x = cvt_pk_bf16(silu_f(g0[0]) * u0[0], silu_f(g0[1]) * u0[1]); w.y = cvt_pk_bf16(silu_f(g0[2]) * u0[2], silu_f(g0[3]) * u0[3]);
                w.z = cvt_pk_bf16(silu_f(g1[0]) * u1[0], silu_f(g1[1]) * u1[1]); w.w = cvt_pk_bf16(silu_f(g1[2]) * u1[2], silu_f(g1[3]) * u1[3]);
                *(u32x4*)rowp = w; }
    }
};
typedef unsigned u32x2 __attribute__((ext_vector_type(2)));
typedef __bf16 bf16x2b_t __attribute__((ext_vector_type(2)));
__device__ __forceinline__ unsigned cvt_pk_bf16_b(float lo, float hi) { f32x2 v = {lo, hi}; bf16x2b_t r = __builtin_convertvector(v, bf16x2b_t); return __builtin_bit_cast(unsigned, r); }
struct EpiRes {
    static constexpr bool PERM = false, AFTER_DRAIN = true;
    float* x_l; float* x_c; const float* gate; float gs; int nk_full; float* part;
    const float* xin_l; const float* xin_c;
    int fuse, final; bf16_t* H; const float* nsh;
    float* slots; unsigned* cnt;
    __device__ __forceinline__ void operator()(const f32x4 (&acc)[2][2][4][2], const Unit& u, int wr, int wc, int fr, int fq) const {
        const bool lat = u.pm < 64; const int s = lat ? (u.pm >> 3) : 8; const size_t r0 = (size_t)(lat ? u.pm : u.pm - 64) * BM;
        const bool whole = (u.nk == nk_full);
        float* xo = whole ? (lat ? x_l : x_c) + r0 * 1024 : part + ((size_t)u.pt * 2048 + r0) * 512;
        const float* xi = (lat ? xin_l : xin_c) + r0 * 1024;
        const int col0 = u.pn * BM + wc * 32 + 4 * fq;
        f32x4 gv[2][2];
#pragma unroll
        for (int bj = 0; bj < 2; ++bj)
#pragma unroll
            for (int n = 0; n < 2; ++n) gv[bj][n] = *(const f32x4*)(gate + s * 9216 + col0 + bj * HALF + n * 16) * gs;
        if (whole) {
#pragma unroll
            for (int ai = 0; ai < 2; ++ai)
#pragma unroll
                for (int m = 0; m < 4; ++m) { const unsigned off = (unsigned)(ai * HALF + wr * 64 + m * 16 + fr) * 1024u + (unsigned)col0;
#pragma unroll
                    for (int bj = 0; bj < 2; ++bj)
#pragma unroll
                        for (int n = 0; n < 2; ++n) { const f32x4 x = *(const f32x4*)(xi + off + bj * HALF + n * 16);
                            *(f32x4*)(xo + off + bj * HALF + n * 16) = x + gv[bj][n] * acc[ai][bj][m][n]; } }
        } else {
#pragma unroll
            for (int ai = 0; ai < 2; ++ai)
#pragma unroll
                for (int m = 0; m < 4; ++m) { const unsigned off = (unsigned)(ai * HALF + wr * 64 + m * 16 + fr) * 1024u + (unsigned)col0;
#pragma unroll
                    for (int bj = 0; bj < 2; ++bj)
#pragma unroll
                        for (int n = 0; n < 2; ++n) { const f32x4 pv = gv[bj][n] * acc[ai][bj][m][n];
                            u32x2 w2; w2.x = cvt_pk_bf16_b(pv[0], pv[1]); w2.y = cvt_pk_bf16_b(pv[2], pv[3]);
                            *(u32x2*)((bf16_t*)xo + off + bj * HALF + n * 16) = w2; } }
        }
    }
    __device__ __forceinline__ void fused(const f32x4 (&acc)[2][2][4][2], const Unit& u, int wr_, int wc_, int fr_, int fq_, PG8_LAS unsigned char* lds, int wid_, int lane_) const {
        const int tid2 = tid_now(), wid = __builtin_amdgcn_readfirstlane(tid2 >> 6), lane = tid2 & 63, wr = wid >> 2, wc = wid & 3, fr = lane & 15, fq = lane >> 4;
        const bool whole = (u.nk == nk_full);
        if (!fuse || !whole || u.pm >= 64) { (*this)(acc, u, wr, wc, fr, fq); return; }
        const int s = u.pm >> 3; float* xo = x_l + (size_t)u.pm * BM * 1024;
        const int col0 = u.pn * BM + wc * 32 + 4 * fq;
        PG8_LAS float* P = (PG8_LAS float*)lds;
        PG8_LAS float* S = (PG8_LAS float*)(lds + 8192);
        {   const float* gp = gate + s * 9216 + col0;
#pragma unroll
            for (int ai = 0; ai < 2; ++ai)
#pragma unroll
                for (int m = 0; m < 4; ++m) { const int r = ai * HALF + wr * 64 + m * 16 + fr; const unsigned eo = (unsigned)(u.pm * BM + r) * 1024u + (unsigned)col0;
                    float* xr = x_l + eo; const float* xir = xin_l + eo; float q = 0.f;
#pragma unroll
                    for (int bj = 0; bj < 2; ++bj)
#pragma unroll
                        for (int n = 0; n < 2; ++n) { const f32x4 x = *(const f32x4*)(xir + bj * HALF + n * 16); const f32x4 gvv = *(const f32x4*)(gp + bj * HALF + n * 16) * gs;
                            const f32x4 y = x + gvv * acc[ai][bj][m][n];
                            *(f32x4*)(xr + bj * HALF + n * 16) = y;
                            q += (y[0] * y[0] + y[1] * y[1]) + (y[2] * y[2] + y[3] * y[3]); }
                    q += __shfl_xor(q, 16); q += __shfl_xor(q, 32);
                    if (fq == 0) P[r * 4 + wc] = q;
                    asm volatile("" ::: "memory"); }
        }
        asm volatile("s_waitcnt lgkmcnt(0)" ::: "memory"); __builtin_amdgcn_s_barrier(); asm volatile("" ::: "memory");
        const int tid = wid * 64 + lane;
        if (tid < 256) { const float t = (P[tid * 4 + 0] + P[tid * 4 + 1]) + (P[tid * 4 + 2] + P[tid * 4 + 3]);
            __hip_atomic_store(slots + ((size_t)(u.pm * BM + tid) * 4 + u.pn), t, __ATOMIC_RELAXED, __HIP_MEMORY_SCOPE_AGENT); }
        asm volatile("s_waitcnt vmcnt(0)" ::: "memory");
        if (tid < 256 && lane == 0) __hip_atomic_fetch_add(cnt + 16 * u.pm, 1u, __ATOMIC_RELAXED, __HIP_MEMORY_SCOPE_AGENT);
        if (wid == 0) { unsigned spins = 0;
            while ((unsigned)__builtin_amdgcn_readfirstlane((int)__hip_atomic_load(cnt + 16 * u.pm, __ATOMIC_RELAXED, __HIP_MEMORY_SCOPE_AGENT)) < 16u) { __builtin_amdgcn_s_sleep(2); if (++spins > (1u << 22)) break; }
            __builtin_amdgcn_fence(__ATOMIC_ACQUIRE, "agent"); }
        asm volatile("s_waitcnt vmcnt(0) lgkmcnt(0)" ::: "memory"); __builtin_amdgcn_s_barrier(); asm volatile("" ::: "memory");
        if (tid < 256) { const float* sp = slots + (size_t)(u.pm * BM + tid) * 4; float t = 0.f;
#pragma unroll
            for (int k = 0; k < 4; ++k) t += __hip_atomic_load(sp + k, __ATOMIC_RELAXED, __HIP_MEMORY_SCOPE_AGENT);
            S[tid] = 1.0f / sqrtf(t * (1.0f / 1024.0f) + 1e-6f); }
        asm volatile("s_waitcnt vmcnt(0) lgkmcnt(0)" ::: "memory"); __builtin_amdgcn_s_barrier(); asm volatile("" ::: "memory");
        if (final) {
            f32x4 gg[2][2];
#pragma unroll
            for (int bj = 0; bj < 2; ++bj)
#pragma unroll
                for (int n = 0; n < 2; ++n) gg[bj][n] = *(const f32x4*)(nsh + col0 + bj * HALF + n * 16);
#pragma unroll
            for (int ai = 0; ai < 2; ++ai)
#pragma unroll
                for (int m = 0; m < 4; ++m) { const int r = ai * HALF + wr * 64 + m * 16 + fr; const float rr = S[r]; const size_t off = (size_t)r * 1024 + col0;
#pragma unroll
                    for (int bj = 0; bj < 2; ++bj)
#pragma unroll
                        for (int n = 0; n < 2; ++n) { const f32x4 y = *(const f32x4*)(xo + off + bj * HALF + n * 16); __builtin_nontemporal_store(y * rr * gg[bj][n], (f32x4*)(xo + off + bj * HALF + n * 16)); }
                    asm volatile("" ::: "memory"); }
        } else {
            const float* shp = nsh + s * 9216 + col0; bf16_t* hb = H + (size_t)u.pm * BM * 1024 + col0;
            f32x4 sh[2][2], sc[2][2];
#pragma unroll
            for (int bj = 0; bj < 2; ++bj)
#pragma unroll
                for (int n = 0; n < 2; ++n) { sh[bj][n] = *(const f32x4*)(shp + bj * HALF + n * 16); sc[bj][n] = *(const f32x4*)(shp + 1024 + bj * HALF + n * 16) + 1.0f; }
#pragma unroll
            for (int ai = 0; ai < 2; ++ai)
#pragma unroll
                for (int m = 0; m < 4; ++m) { const int r = ai * HALF + wr * 64 + m * 16 + fr; const float rr = S[r];
#pragma unroll
                    for (int bj = 0; bj < 2; ++bj)
#pragma unroll
                        for (int n = 0; n < 2; ++n) { const f32x4 y = *(const f32x4*)(xo + (size_t)r * 1024 + col0 + bj * HALF + n * 16); const f32x4 o = y * rr * sc[bj][n] + sh[bj][n];
                            *(unsigned long long*)(hb + (size_t)r * 1024 + bj * HALF + n * 16) = (unsigned long long)cvt_pk_bf16(o[0], o[1]) | ((unsigned long long)cvt_pk_bf16(o[2], o[3]) << 32); }
                    asm volatile("" ::: "memory"); }
        }
    }
};
struct EpiQKV {
    static constexpr bool PERM = true, AFTER_DRAIN = false;
    bf16_t* Qb; bf16_t* Kb; bf16_t* Vtb; const float* rope; const float* qng; const float* kng; PG8_LAS unsigned char* stage;
    __device__ __forceinline__ void operator()(const f32x4 (&acc)[2][2][4][2], const Unit& u, int wr, int wc, int fr, int fq) const {
        constexpr int POSN = 2304;
        const int lane = fq * 16 + fr;
        PG8_LAS unsigned char* slab = stage + (wr * 4 + wc) * 2560;
        const int ch = u.pn * 4 + wc;
        int mixer, kind, hh;
        if (ch < 16) { mixer = ch >> 3; const int cc = ch & 7; kind = cc < 4 ? 0 : (cc < 6 ? 1 : 2); hh = cc < 4 ? cc : (cc < 6 ? cc - 4 : cc - 6); }
        else { const int cc = (ch < 28) ? ch - 16 : ch - 28; mixer = (ch < 28) ? 2 : 3; kind = cc >> 2; hh = cc & 3; }
        const int kvbase = mixer == 0 ? 0 : (mixer == 1 ? 2 : (mixer == 2 ? 4 : 8));
        const bool lat = u.pm < 64; const int b = lat ? (u.pm >> 3) : (u.pm - 64); const int posbase = lat ? (u.pm & 7) * 256 : 2048;
        const bool t32 = (mixer == 3) && (kind < 2);
        int dof[2][2];
#pragma unroll
        for (int bj = 0; bj < 2; ++bj)
#pragma unroll
            for (int n = 0; n < 2; ++n) dof[bj][n] = t32 ? (32 * bj + 16 * (fq >> 1) + 8 * n + 4 * (fq & 1)) : (32 * bj + 16 * n + 4 * fq);
        if (kind == 2) {
            bf16_t* vb = Vtb + (size_t)((kvbase + hh) * 8 + b) * 64 * POSN + (size_t)(posbase + wr * 64) * 64 + lane * 16;
#pragma unroll
            for (int ai = 0; ai < 2; ++ai)
#pragma unroll
                for (int m = 0; m < 4; ++m) {
#pragma unroll
                    for (int bj = 0; bj < 2; ++bj)
#pragma unroll
                        for (int n = 0; n < 2; ++n) { const f32x4 v = acc[ai][bj][m][n]; const int d0 = dof[bj][n];
                            const unsigned w0 = cvt_pk_bf16(v[0], v[1]), w1 = cvt_pk_bf16(v[2], v[3]);
                            PG8_LAS bf16_t* sp = (PG8_LAS bf16_t*)(slab + d0 * 40 + fr * 2);
                            sp[0] = (bf16_t)(w0 & 0xffffu); sp[20] = (bf16_t)(w0 >> 16); sp[40] = (bf16_t)(w1 & 0xffffu); sp[60] = (bf16_t)(w1 >> 16); }
                    asm volatile("" ::: "memory");
                    typedef unsigned long long u64s;
                    const PG8_LAS u64s* rp = (const PG8_LAS u64s*)(slab + lane * 40);
                    const u64s r0 = rp[0], r1 = rp[1], r2 = rp[2], r3 = rp[3];
                    asm volatile("" ::: "memory");
                    bf16_t* dst = vb + (size_t)(ai * HALF + m * 16) * 64;
                    u32x4 o0, o1; o0.x = (unsigned)r0; o0.y = (unsigned)(r0 >> 32); o0.z = (unsigned)r1; o0.w = (unsigned)(r1 >> 32); o1.x = (unsigned)r2; o1.y = (unsigned)(r2 >> 32); o1.z = (unsigned)r3; o1.w = (unsigned)(r3 >> 32);
                    *(u32x4*)dst = o0; *(u32x4*)(dst + 8) = o1; }
            return;
        }
        const float qs = (kind == 0) ? ((mixer == 3 ? 0.17677669529663687f : 0.125f) * 1.44269504f) : 1.0f;
        bf16_t* ob = (kind == 0) ? Qb + (size_t)((mixer * 8 + b) * 4 + hh) * POSN * 64 : Kb + (size_t)((kvbase + hh) * 8 + b) * POSN * 64;
        f32x4 gv[2][2];
        if (mixer == 1) { const float* gp = (kind == 0) ? qng : kng;
#pragma unroll
            for (int bj = 0; bj < 2; ++bj)
#pragma unroll
                for (int n = 0; n < 2; ++n) gv[bj][n] = *(const f32x4*)(gp + dof[bj][n]); }
#pragma unroll
        for (int ai = 0; ai < 2; ++ai)
#pragma unroll
            for (int m = 0; m < 4; ++m) {
                const int pos = posbase + ai * HALF + wr * 64 + m * 16 + fr;
                f32x4 v[2][2];
#pragma unroll
                for (int bj = 0; bj < 2; ++bj)
#pragma unroll
                    for (int n = 0; n < 2; ++n) v[bj][n] = acc[ai][bj][m][n];
                if (mixer == 1) {
                    float ss = 0.f;
#pragma unroll
                    for (int bj = 0; bj < 2; ++bj)
#pragma unroll
                        for (int n = 0; n < 2; ++n) ss += (v[bj][n][0] * v[bj][n][0] + v[bj][n][1] * v[bj][n][1]) + (v[bj][n][2] * v[bj][n][2] + v[bj][n][3] * v[bj][n][3]);
                    ss += __shfl_xor(ss, 16); ss += __shfl_xor(ss, 32);
                    const float rr = 1.0f / sqrtf(ss * (1.0f / 64.0f) + 1e-6f);
#pragma unroll
                    for (int bj = 0; bj < 2; ++bj)
#pragma unroll
                        for (int n = 0; n < 2; ++n) v[bj][n] = v[bj][n] * rr * gv[bj][n];
                }
                if (lat && mixer < 2) {
                    const int grow = pos >> 6, gcol = pos & 63;
#pragma unroll
                    for (int bj = 0; bj < 2; ++bj) { const float* rp = rope + (bj ? gcol : grow) * 16 + 4 * fq;
                        const f32x4 c4 = *(const f32x4*)rp, s4 = *(const f32x4*)(rp + 1024);
                        const f32x4 x0 = v[bj][0], x1 = v[bj][1];
                        v[bj][0] = x0 * c4 - x1 * s4; v[bj][1] = x1 * c4 + x0 * s4; }
                } else if (lat && mixer == 3) {
                    const int p = (fq & 2) ? (pos & 63) : (pos >> 6);
                    const float* rp = rope + 2048 + p * 8 + 4 * (fq & 1); const f32x4 c4 = *(const f32x4*)rp, s4 = *(const f32x4*)(rp + 512);
#pragma unroll
                    for (int bj = 0; bj < 2; ++bj) { const f32x4 x0 = v[bj][0], x1 = v[bj][1];
                        v[bj][0] = x0 * c4 - x1 * s4; v[bj][1] = x1 * c4 + x0 * s4; }
                }
#pragma unroll
                for (int bj = 0; bj < 2; ++bj)
#pragma unroll
                    for (int n = 0; n < 2; ++n) { const f32x4 a = v[bj][n] * qs;
                        *(PG8_LAS unsigned long long*)(slab + fr * 136 + dof[bj][n] * 2) = (unsigned long long)cvt_pk_bf16(a[0], a[1]) | ((unsigned long long)cvt_pk_bf16(a[2], a[3]) << 32); }
                asm volatile("" ::: "memory");
                typedef unsigned long long u64s;
                const PG8_LAS u64s* rp = (const PG8_LAS u64s*)(slab + (lane >> 2) * 136 + (lane & 3) * 32);
                const u64s r0 = rp[0], r1 = rp[1], r2 = rp[2], r3 = rp[3];
                asm volatile("" ::: "memory");
                bf16_t* dst = ob + (size_t)(posbase + ai * HALF + wr * 64 + m * 16) * 64 + lane * 16;
                u32x4 o0, o1; o0.x = (unsigned)r0; o0.y = (unsigned)(r0 >> 32); o0.z = (unsigned)r1; o0.w = (unsigned)(r1 >> 32); o1.x = (unsigned)r2; o1.y = (unsigned)(r2 >> 32); o1.z = (unsigned)r3; o1.w = (unsigned)(r3 >> 32);
                *(u32x4*)dst = o0; *(u32x4*)(dst + 8) = o1;
            }
    }
};
struct SplitOrder {
    StaticOrder so; int P;
    __host__ __device__ void init(int M, int N, int G_, int c_, int K_) {
        P = (M == 18432 && N == 1024 && G_ == 256 && (K_ / BK) >= 16) ? 8 : 0;
#ifdef NO_SPLIT
        P = 0;
#endif
        so.init(P ? 16384 : M, N, G_, c_, K_);
    }
    __host__ __device__ bool next(int i, Unit& u) const {
        Unit a; a.pm = 0; a.pn = 0; a.k0 = 0; a.nk = so.nK; a.pt = 0;
        bool ok;
        if (P == 0) ok = so.next(i, a);
        else {
            ok = so.next(0, a) && (i <= 1);
            if (i == 0) {
                const int t = so.c >> 3, p = so.c & 7, h = so.nK / 2, q = h / P, r = h % P;
                a.pm = 64 + (t >> 2); a.pn = t & 3; a.pt = p;
                a.k0 = 2 * (p * q + (p < r ? p : r)); a.nk = 2 * (q + (p < r ? 1 : 0));
            }
        }
        u = a; return ok;
    }
    __device__ __forceinline__ void a_ready(const Unit&) const {}
    __device__ __forceinline__ void done(const Unit&) const {}
};
}

#define LAS __attribute__((address_space(3)))
typedef unsigned short bf16_t;
typedef short bf16x8 __attribute__((ext_vector_type(8)));
typedef float f32x4 __attribute__((ext_vector_type(4)));
typedef unsigned u32x4 __attribute__((ext_vector_type(4)));
typedef unsigned u32x2 __attribute__((ext_vector_type(2)));
constexpr int NT = 512;
constexpr int DM = 1024, SEQ = 2048, NBATCH = 8, CTXL = 256, DFF = 2816, INW = 2560;
constexpr int ML = NBATCH * SEQ, MC = NBATCH * CTXL, MT = ML + MC;
constexpr int POS = SEQ + CTXL;
constexpr float LOG2E = 1.44269504f;
constexpr int LDS_BYTES = 152576;
#ifndef REP_SYNC
#define REP_SYNC 1
#endif
#define GSYNC() do { for (int r_ = 0; r_ < REP_SYNC; ++r_) { XcdBarrier xb_; xb_.bar = (unsigned*)(ldws() + WS_BAR); xb_.x = xb_xcc_id(); xb_.st = (volatile LAS unsigned*)(lds + MISC_OFF); xcd_barrier(xb_); } } while (0)
constexpr int MISC_OFF = LDS_BYTES - 64;
#ifdef NO_SPLIT
#define SPLIT_PART ((const float*)nullptr)
#else
#define SPLIT_PART ((GRD == 256) ? (const float*)WSF(WS_Q) : (const float*)nullptr)
#endif
#ifndef REP_ATT
#define REP_ATT 1
#endif
#ifndef REP_LIGHT
#define REP_LIGHT 1
#endif
#ifndef REP_GU
#define REP_GU 1
#endif
constexpr size_t MiB = 1u << 20;
constexpr size_t WS_CTL = 0, WS_BAR = 16384, WS_CNT = 32768, CTL_ZERO_BYTES = 65536, WS_ROPE = 65536, WS_SCAL = 131072, WS_MOD = 262144;
constexpr size_t WS_W = 1 * MiB;
constexpr size_t W_GU1 = 0, W_D1 = 11 * MiB, W_IN = 16 * MiB + 512 * 1024, W_OUT = 21 * MiB + 512 * 1024, W_GU2 = 23 * MiB + 512 * 1024, W_D2 = 34 * MiB + 512 * 1024;
constexpr size_t WS_XC = 41 * MiB, WS_H = 49 * MiB, WS_G = 85 * MiB, WS_Q = 184 * MiB, WS_K = 220 * MiB, WS_VT = 247 * MiB, WS_SLOTS = 274 * MiB, WS_END = 275 * MiB;

__device__ __forceinline__ float bf2f(bf16_t v) { return __builtin_bit_cast(float, (unsigned)v << 16); }
__device__ __forceinline__ unsigned pk2(float lo, float hi) { return pg8::cvt_pk_bf16(lo, hi); }
__device__ __forceinline__ bf16_t f2bf(float v) { return (bf16_t)(pk2(v, 0.f) & 0xffffu); }
__device__ __forceinline__ float wave_sum(float v) {
#pragma unroll
    for (int o = 1; o < 64; o <<= 1) v += __shfl_xor(v, o);
    return v;
}
#define LDS_WAIT() asm volatile("s_waitcnt lgkmcnt(0)" ::: "memory")
#define XB_TMO      128
#define XB_XCNT(j)  (256  + 64 * (j))
#define XB_XSUB(j)  (1280 + 64 * (j))
#define XB_XGEN(j)  (2304 + 64 * (j))
#define XB_TOP      3328
#define XB_TOPGEN   3392
#define XCD_BAR_WORDS 3456
#define XB_SPIN_CAP (1u << 18)

__device__ __forceinline__ unsigned xb_ld(unsigned* p)              { return __hip_atomic_load(p, __ATOMIC_RELAXED, __HIP_MEMORY_SCOPE_AGENT); }
__device__ __forceinline__ unsigned xb_add(unsigned* p, unsigned v) { return __hip_atomic_fetch_add(p, v, __ATOMIC_RELAXED, __HIP_MEMORY_SCOPE_AGENT); }
__device__ __forceinline__ unsigned xb_xcc_id() { return (unsigned)__builtin_amdgcn_s_getreg((3 << 11) | 20) & 0xFu; }
#define XB_SPIN(cond, bar) do { unsigned _sp = 0; while (cond) { __builtin_amdgcn_s_sleep(1); \
    if ((++_sp & 255u) == 0u) { if (xb_ld(&(bar)[XB_TMO])) break; if (_sp > XB_SPIN_CAP) { atomicAdd(&(bar)[XB_TMO], 1u); break; } } } } while (0)

struct XcdBarrier {
    unsigned* bar; unsigned x;
    volatile LAS unsigned* st;
};

__device__ __forceinline__ XcdBarrier xcd_barrier_post(unsigned* bar, volatile LAS unsigned* st) {
    XcdBarrier b; b.bar = bar; b.x = xb_xcc_id(); b.st = st;
    if (threadIdx.x == 0) (void)xb_add(&bar[XB_XCNT(b.x)], 1u);
    return b;
}
__device__ __forceinline__ void xcd_barrier_complete(unsigned* bar, unsigned x, unsigned& nloc, unsigned& nx) {
    const unsigned G = gridDim.x * gridDim.y * gridDim.z;
    unsigned sum, cnt, mine, sp = 0u;
    for (;;) {
        sum = 0u; cnt = 0u; mine = 0u;
#pragma unroll
        for (unsigned j = 0; j < 16; ++j) { const unsigned c = xb_ld(&bar[XB_XCNT(j)]); sum += c; cnt += (c > 0u) ? 1u : 0u; mine = (j == x) ? c : mine; }
        if (sum == G) break;
        __builtin_amdgcn_s_sleep(1);
        if ((++sp & 255u) == 0u) { if (xb_ld(&bar[XB_TMO])) break; if (sp > XB_SPIN_CAP) { atomicAdd(&bar[XB_TMO], 1u); break; } }
    }
    nloc = mine > 0u ? mine : 1u; nx = cnt > 0u ? cnt : 1u;
}

__device__ __forceinline__ void xcd_barrier(const XcdBarrier& b) {
    asm volatile("s_waitcnt vmcnt(0)" ::: "memory");
    __syncthreads();
    if (threadIdx.x == 0) {
        unsigned* bar = b.bar;
        __builtin_amdgcn_s_waitcnt(0);
        unsigned nloc = b.st[0], nx = b.st[1];
        if (nloc == 0u) { xcd_barrier_complete(bar, b.x, nloc, nx); b.st[0] = nloc; b.st[1] = nx; }
        const unsigned old = xb_add(&bar[XB_XSUB(b.x)], 1u);
        const unsigned gen = old / nloc;
        if (old + 1u == (gen + 1u) * nloc) {
            __builtin_amdgcn_fence(__ATOMIC_RELEASE, "agent");
            asm volatile("s_waitcnt vmcnt(0)" ::: "memory");
            const unsigned og = xb_add(&bar[XB_TOP], 1u);
            const unsigned tg = og / nx;
            if (og + 1u == (tg + 1u) * nx) xb_add(&bar[XB_TOPGEN], 1u);
            else XB_SPIN(xb_ld(&bar[XB_TOPGEN]) == tg, bar);
            __builtin_amdgcn_fence(__ATOMIC_ACQUIRE, "agent");
            xb_add(&bar[XB_XGEN(b.x)], 1u);
            asm volatile("s_waitcnt vmcnt(0)" ::: "memory");
        } else {
            XB_SPIN(xb_ld(&bar[XB_XGEN(b.x)]) == gen, bar);
            __builtin_amdgcn_fence(__ATOMIC_ACQUIRE, "agent");
            asm volatile("s_waitcnt vmcnt(0)" ::: "memory");
        }
    }
    __syncthreads();
}


__device__ __forceinline__ void p0_mod(LAS unsigned char* lds, const float* c, const float* cctx, const float* w_ada, const float* b_ada, float* MOD, int bid, int G, int tid) {
    LAS float* sl = (LAS float*)lds;
    LAS float* red = (LAS float*)(lds + 36864);
    for (int i = tid; i < 9 * 1024; i += NT) { const float v = i < 8192 ? c[i] : cctx[i - 8192]; sl[i] = v / (1.0f + expf(-v)); }
    __syncthreads();
    const int col = tid & 63, kg = tid >> 6;
    for (int item = bid; item < 2 * 144; item += G) {
        const int l = item / 144, n0 = (item % 144) * 64;
        const float* w = w_ada + (size_t)l * 1024 * 9216 + n0 + col;
        float acc[9];
#pragma unroll
        for (int s = 0; s < 9; ++s) acc[s] = 0.f;
#pragma unroll 16
        for (int k = kg * 128; k < kg * 128 + 128; ++k) { const float wv = __builtin_nontemporal_load(&w[(size_t)k * 9216]);
#pragma unroll
            for (int s = 0; s < 9; ++s) acc[s] += sl[s * 1024 + k] * wv; }
#pragma unroll
        for (int s = 0; s < 9; ++s) red[(kg * 9 + s) * 64 + col] = acc[s];
        __syncthreads();
        for (int i = tid; i < 9 * 64; i += NT) { const int s = i >> 6, cc = i & 63; float v = b_ada[l * 9216 + n0 + cc];
#pragma unroll
            for (int g = 0; g < 8; ++g) v += red[(g * 9 + s) * 64 + cc];
            MOD[((size_t)l * 9 + s) * 9216 + n0 + cc] = v; }
        __syncthreads();
    }
}
__device__ __forceinline__ void p0_misc(float* rope, float* scal, const float* lq1, const float* lk1, const float* lq2, const float* lk2, int tid) {
    for (int i = tid; i < 1024; i += NT) { const int p = i >> 4, f = i & 15; const float fr = exp2f(-(float)f * (13.287712379549449f / 16.0f)); const float a = (float)p * fr; rope[i] = __cosf(a); rope[1024 + i] = __sinf(a); }
    for (int i = tid; i < 512; i += NT) { const int p = i >> 3, f = i & 7; const float fr = exp2f(-(float)f * (13.287712379549449f / 8.0f)); const float a = (float)p * fr; rope[2048 + i] = __cosf(a); rope[2560 + i] = __sinf(a); }
    if (tid < 2) { const int l = tid; float d1 = 0.f, d2 = 0.f;
        for (int k = 0; k < 32; ++k) { d1 += lq1[l * 32 + k] * lk1[l * 32 + k]; d2 += lq2[l * 32 + k] * lk2[l * 32 + k]; }
        const float lam_init = 0.8f - 0.6f * expf(-0.3f * (float)l);
        scal[l] = expf(d1) - expf(d2) + lam_init; }
}

__device__ __forceinline__ void transpose_item(const float* W, int K, int N, bf16_t* WT, int mode, LAS float* scr, int item, int lane) {
    const int nblk = N / 32, kb = item / nblk, nb = item % nblk, k0 = 64 * kb, n0 = 32 * nb;
    const int g8 = (n0 >> 5) & 7;
    const int drow0 = mode == 0 ? n0 : (mode == 3 ? ((n0 & ~255) + 32 * (4 * (g8 & 1) + (g8 >> 1))) : ((n0 >> 7) * 256 + (n0 & 127) + (mode == 2 ? 128 : 0)));
    float wv[32];
#pragma unroll
    for (int i = 0; i < 32; ++i) wv[i] = __builtin_nontemporal_load(&W[(size_t)(k0 + 2 * i + (lane >> 5)) * N + n0 + (lane & 31)]);
#pragma unroll
    for (int i = 0; i < 32; ++i) scr[(2 * i + (lane >> 5)) * 33 + (lane & 31)] = wv[i];
    LDS_WAIT(); asm volatile("" ::: "memory");
    const int c = lane & 7;
#pragma unroll
    for (int j = 0; j < 4; ++j) { const int n = (lane >> 3) + 8 * j; const LAS float* s = scr + (8 * c) * 33 + n;
        u32x4 o; o.x = pk2(s[0 * 33], s[1 * 33]); o.y = pk2(s[2 * 33], s[3 * 33]); o.z = pk2(s[4 * 33], s[5 * 33]); o.w = pk2(s[6 * 33], s[7 * 33]);
        int nn = n;
        if (mode == 3) { const bool t32 = (n0 >> 6) >= 28 && (n0 >> 6) < 36;
            nn = t32 ? (8 * (2 * ((n >> 4) & 1) + ((n >> 2) & 1)) + 4 * ((n >> 3) & 1) + (n & 3)) : (8 * ((n >> 2) & 3) + 4 * (n >> 4) + (n & 3)); }
        *(u32x4*)(WT + (size_t)(drow0 + nn) * K + k0 + 8 * c) = o; }
    LDS_WAIT(); asm volatile("" ::: "memory");
}
__device__ __forceinline__ void convert_layer(LAS unsigned char* lds, int l, const float* g1, const float* u1, const float* d1, const float* win, const float* wout,
                                              const float* g2, const float* u2, const float* d2, unsigned char* wsW, int gw, int NGW, int wave, int lane) {
    LAS float* scr = (LAS float*)(lds + wave * 8448);
    const size_t offF = (size_t)l * DM * DFF;
    constexpr int I_GU = 16 * 88, I_D = 44 * 32, I_IN = 16 * 80, I_OUT = 16 * 32;
    constexpr int NITEMS = 6 * I_GU + I_IN + I_OUT;
    for (int it = gw; it < NITEMS; it += NGW) {
        int r = it;
        if (r < I_GU) { transpose_item(g1 + offF, DM, DFF, (bf16_t*)(wsW + W_GU1), 1, scr, r, lane); continue; } r -= I_GU;
        if (r < I_GU) { transpose_item(u1 + offF, DM, DFF, (bf16_t*)(wsW + W_GU1), 2, scr, r, lane); continue; } r -= I_GU;
        if (r < I_D)  { transpose_item(d1 + offF, DFF, DM, (bf16_t*)(wsW + W_D1), 0, scr, r, lane); continue; } r -= I_D;
        if (r < I_GU) { transpose_item(g2 + offF, DM, DFF, (bf16_t*)(wsW + W_GU2), 1, scr, r, lane); continue; } r -= I_GU;
        if (r < I_GU) { transpose_item(u2 + offF, DM, DFF, (bf16_t*)(wsW + W_GU2), 2, scr, r, lane); continue; } r -= I_GU;
        if (r < I_D)  { transpose_item(d2 + offF, DFF, DM, (bf16_t*)(wsW + W_D2), 0, scr, r, lane); continue; } r -= I_D;
        if (r < I_IN) { transpose_item(win + (size_t)l * DM * INW, DM, INW, (bf16_t*)(wsW + W_IN), 3, scr, r, lane); continue; } r -= I_IN;
        transpose_item(wout + (size_t)l * DM * DM, DM, DM, (bf16_t*)(wsW + W_OUT), 0, scr, r, lane);
    }
}

__device__ __forceinline__ void norm_mod_row(const float* xr, float* cp, bf16_t* hrow, const float* sh, const float* sc, int lane) {
    f32x4 v[4]; float ss = 0.f;
#pragma unroll
    for (int j = 0; j < 4; ++j) { v[j] = *(const f32x4*)(xr + 4 * lane + 256 * j); ss += (v[j].x * v[j].x + v[j].y * v[j].y) + (v[j].z * v[j].z + v[j].w * v[j].w); }
    if (cp) {
#pragma unroll
        for (int j = 0; j < 4; ++j) *(f32x4*)(cp + 4 * lane + 256 * j) = v[j];
    }
    ss = wave_sum(ss);
    const float rr = 1.0f / sqrtf(ss * (1.0f / DM) + 1e-6f);
    unsigned long long* o8 = (unsigned long long*)hrow + lane;
#pragma unroll
    for (int j = 0; j < 4; ++j) { const f32x4 a = *(const f32x4*)(sh + 4 * lane + 256 * j), b = *(const f32x4*)(sc + 4 * lane + 256 * j);
        const f32x4 o = v[j] * rr * (b + 1.0f) + a;
        o8[64 * j] = (unsigned long long)pk2(o.x, o.y) | ((unsigned long long)pk2(o.z, o.w) << 32); }
}
__device__ __forceinline__ void norm_mod_phase(const float* xl, const float* xc, float* cpl, float* cpc, const float* part, float* xcw, bf16_t* H, const float* modl, int sidx, int rbegin, int nrows, int gw, int ngw, int lane) {
    for (int r = rbegin + gw; r < nrows; r += 2 * ngw) {
        const int r2 = r + ngw; const bool two = r2 < nrows;
        const bool lat = r < ML; const size_t ro = lat ? (size_t)r * DM : (size_t)(r - ML) * DM; const int s = lat ? (r >> 11) : 8;
        const float* sh = modl + s * 9216 + sidx * 1024;
        const bool lat2 = r2 < ML; const size_t ro2 = lat2 ? (size_t)r2 * DM : (size_t)(r2 - ML) * DM; const int s2 = lat2 ? (r2 >> 11) : 8;
        const float* sh2 = modl + s2 * 9216 + sidx * 1024;
        const float* xr = (lat ? xl : xc) + ro; const float* xr2 = (lat2 ? xl : xc) + ro2;
        f32x4 v[4], w[4]; float ss = 0.f, ss2 = 0.f;
#pragma unroll
        for (int j = 0; j < 4; ++j) { v[j] = __builtin_nontemporal_load((const f32x4*)(xr + 4 * lane + 256 * j)); }
        if (two) {
#pragma unroll
            for (int j = 0; j < 4; ++j) { w[j] = __builtin_nontemporal_load((const f32x4*)(xr2 + 4 * lane + 256 * j)); }
        } else {
#pragma unroll
            for (int j = 0; j < 4; ++j) w[j] = (f32x4){0.f, 0.f, 0.f, 0.f};
        }
        if (part && !lat) {
#pragma unroll
            for (int p = 0; p < 8; ++p) { const bf16_t* pp = (const bf16_t*)part + (size_t)p * 2048 * 1024 + ro;
#pragma unroll
                for (int j = 0; j < 4; ++j) { const u32x2 q = *(const u32x2*)(pp + 4 * lane + 256 * j);
                    v[j] += (f32x4){__builtin_bit_cast(float, q.x << 16), __builtin_bit_cast(float, q.x & 0xffff0000u), __builtin_bit_cast(float, q.y << 16), __builtin_bit_cast(float, q.y & 0xffff0000u)}; } }
            float* cp = xcw + ro;
#pragma unroll
            for (int j = 0; j < 4; ++j) *(f32x4*)(cp + 4 * lane + 256 * j) = v[j];
        }
        if (part && two && !lat2) {
#pragma unroll
            for (int p = 0; p < 8; ++p) { const bf16_t* pp = (const bf16_t*)part + (size_t)p * 2048 * 1024 + ro2;
#pragma unroll
                for (int j = 0; j < 4; ++j) { const u32x2 q = *(const u32x2*)(pp + 4 * lane + 256 * j);
                    w[j] += (f32x4){__builtin_bit_cast(float, q.x << 16), __builtin_bit_cast(float, q.x & 0xffff0000u), __builtin_bit_cast(float, q.y << 16), __builtin_bit_cast(float, q.y & 0xffff0000u)}; } }
            float* cp = xcw + ro2;
#pragma unroll
            for (int j = 0; j < 4; ++j) *(f32x4*)(cp + 4 * lane + 256 * j) = w[j];
        }
#pragma unroll
        for (int j = 0; j < 4; ++j) { ss += (v[j].x * v[j].x + v[j].y * v[j].y) + (v[j].z * v[j].z + v[j].w * v[j].w); ss2 += (w[j].x * w[j].x + w[j].y * w[j].y) + (w[j].z * w[j].z + w[j].w * w[j].w); }
        if (cpl) { float* cp = (lat ? cpl : cpc) + ro;
#pragma unroll
            for (int j = 0; j < 4; ++j) *(f32x4*)(cp + 4 * lane + 256 * j) = v[j];
            if (two) { float* cp2 = (lat2 ? cpl : cpc) + ro2;
#pragma unroll
                for (int j = 0; j < 4; ++j) *(f32x4*)(cp2 + 4 * lane + 256 * j) = w[j]; } }
#pragma unroll
        for (int o = 1; o < 64; o <<= 1) { ss += __shfl_xor(ss, o); ss2 += __shfl_xor(ss2, o); }
        const float rr = 1.0f / sqrtf(ss * (1.0f / DM) + 1e-6f), rr2 = 1.0f / sqrtf(ss2 * (1.0f / DM) + 1e-6f);
        unsigned long long* o8 = (unsigned long long*)(H + (size_t)r * DM) + lane;
#pragma unroll
        for (int j = 0; j < 4; ++j) { const f32x4 a = *(const f32x4*)(sh + 4 * lane + 256 * j), b = *(const f32x4*)(sh + 1024 + 4 * lane + 256 * j);
            const f32x4 o = v[j] * rr * (b + 1.0f) + a;
            o8[64 * j] = (unsigned long long)pk2(o.x, o.y) | ((unsigned long long)pk2(o.z, o.w) << 32); }
        if (two) { unsigned long long* p8 = (unsigned long long*)(H + (size_t)r2 * DM) + lane;
#pragma unroll
            for (int j = 0; j < 4; ++j) { const f32x4 a = *(const f32x4*)(sh2 + 4 * lane + 256 * j), b = *(const f32x4*)(sh2 + 1024 + 4 * lane + 256 * j);
                const f32x4 o = w[j] * rr2 * (b + 1.0f) + a;
                p8[64 * j] = (unsigned long long)pk2(o.x, o.y) | ((unsigned long long)pk2(o.z, o.w) << 32); } }
    }
}
__device__ __forceinline__ void final_norm_phase(float* x, const float* g, int gw, int NGW, int lane) {
    for (int r = gw; r < ML; r += NGW) {
        float* xr = x + (size_t)r * DM;
        f32x4 v[4]; float ss = 0.f;
#pragma unroll
        for (int j = 0; j < 4; ++j) { v[j] = *(const f32x4*)(xr + 4 * lane + 256 * j); ss += (v[j].x * v[j].x + v[j].y * v[j].y) + (v[j].z * v[j].z + v[j].w * v[j].w); }
        ss = wave_sum(ss);
        const float rr = 1.0f / sqrtf(ss * (1.0f / DM) + 1e-6f);
#pragma unroll
        for (int j = 0; j < 4; ++j) { const f32x4 a = *(const f32x4*)(g + 4 * lane + 256 * j); *(f32x4*)(xr + 4 * lane + 256 * j) = v[j] * rr * a; }
    }
}

__device__ __forceinline__ void qkv_post_phase(LAS unsigned char* lds, const bf16_t* QKV, bf16_t* Qb, bf16_t* Kb, bf16_t* Vtb, const float* rope, const float* qng, const float* kng,
                                               int bid, int G, int tid, int lane, int wave) {
    LAS bf16_t* T = (LAS bf16_t*)lds;
    const float qg = qng[lane], kg = kng[lane];
    for (int item = bid; item < MT / 32; item += G) {
        const int row0 = item * 32; const bool lat = row0 < ML;
        const int b = lat ? (row0 >> 11) : ((row0 - ML) >> 8);
        const int pos0 = lat ? (row0 & 2047) : 2048 + ((row0 - ML) & 255);
        for (int rr = 0; rr < 4; ++rr) {
            const int tl = wave * 4 + rr, row = row0 + tl, pos = pos0 + tl;
            const int grow = (pos >> 6) & 31, gcol = pos & 63;
            const bf16_t* src = QKV + (size_t)row * INW + lane;
            const int p64 = (lane < 32) ? grow : gcol; const float c64 = rope[p64 * 16 + (lane & 15)], s64 = rope[1024 + p64 * 16 + (lane & 15)];
            const int p32 = (lane & 16) ? gcol : grow; const float c32 = rope[2048 + p32 * 8 + (lane & 7)], s32 = rope[2560 + p32 * 8 + (lane & 7)];
#pragma unroll 1
            for (int ch = 0; ch < 40; ++ch) {
                int mixer, kind, hh;
                if (ch < 16) { mixer = ch >> 3; const int cc = ch & 7; kind = cc < 4 ? 0 : (cc < 6 ? 1 : 2); hh = cc < 4 ? cc : (cc < 6 ? cc - 4 : cc - 6); }
                else { const int cc = (ch < 28) ? ch - 16 : ch - 28; mixer = (ch < 28) ? 2 : 3; kind = cc >> 2; hh = cc & 3; }
                const int kvbase = mixer == 0 ? 0 : (mixer == 1 ? 2 : (mixer == 2 ? 4 : 8));
                const bf16_t raw = src[ch * 64];
                if (kind == 2) { T[((kvbase + hh) * 64 + lane) * 34 + tl] = raw; continue; }
                float v = bf2f(raw);
                if (mixer == 1) { const float ss = wave_sum(v * v); v = v * (1.0f / sqrtf(ss * (1.0f / 64.0f) + 1e-6f)) * (kind == 0 ? qg : kg); }
                if (lat && mixer < 2) { const float pr = __shfl_xor(v, 16); v = v * c64 + ((lane & 16) ? pr : -pr) * s64; }
                else if (lat && mixer == 3) { const float pr = __shfl_xor(v, 8); v = v * c32 + ((lane & 8) ? pr : -pr) * s32; }
                if (kind == 0) { v *= (mixer == 3 ? 0.17677669529663687f : 0.125f) * LOG2E;
                    Qb[((size_t)((mixer * 8 + b) * 4 + hh) * POS + pos) * 64 + lane] = f2bf(v); }
                else Kb[((size_t)((kvbase + hh) * 8 + b) * POS + pos) * 64 + lane] = f2bf(v);
            }
        }
        __syncthreads();
#pragma unroll 1
        for (int p = 0; p < 6; ++p) { const int task = p * NT + tid, rowi = task >> 2, k = task & 3; const int c12 = rowi >> 6, d = rowi & 63;
            const LAS bf16_t* s = T + rowi * 34 + 8 * k;
            u32x4 o; o.x = (unsigned)s[0] | ((unsigned)s[1] << 16); o.y = (unsigned)s[2] | ((unsigned)s[3] << 16); o.z = (unsigned)s[4] | ((unsigned)s[5] << 16); o.w = (unsigned)s[6] | ((unsigned)s[7] << 16);
            *(u32x4*)(Vtb + ((size_t)(c12 * 8 + b) * 64 + d) * POS + pos0 + 8 * k) = o; }
        __syncthreads();
    }
}

#define MFMA16(a, b, c) __builtin_amdgcn_mfma_f32_16x16x32_bf16(a, b, c, 0, 0, 0)
constexpr int KSTR = 72;
constexpr int ABUF_BYTES = 2 * 64 * KSTR * 2;
constexpr int ATT_BIAS_OFF = 2 * ABUF_BYTES, ATT_CUR_OFF = ATT_BIAS_OFF + 2048;
constexpr float RESCALE_TH = 8.0f;
typedef float f32x2_t __attribute__((ext_vector_type(2)));
typedef __bf16 bf16x2_t __attribute__((ext_vector_type(2)));
__device__ __forceinline__ unsigned pk2v(float lo, float hi) { f32x2_t v = {lo, hi}; bf16x2_t b = __builtin_convertvector(v, bf16x2_t); return __builtin_bit_cast(unsigned, b); }
__device__ __forceinline__ float max3f(float a, float b, float c) { float r; asm("v_max3_f32 %0, %1, %2, %3" : "=v"(r) : "v"(a), "v"(b), "v"(c)); return r; }

template <bool DIFF>
__device__ __forceinline__ void attn_unit(LAS unsigned char* lds, const bf16_t* __restrict__ Qp, const bf16_t* __restrict__ Kp, const bf16_t* __restrict__ Vp, bf16_t* __restrict__ Yp,
                                          int q0, int ntiles, int nfirst, int firstpos, int secondpos, int maskmode, float m_init, bool sinkf, const LAS float* bias,
                                          float lam, const float* subg, float oscale, int wave) {
    constexpr int NB = DIFF ? 2 : 1;
    const int tid = tid_now(), lane = tid & 63;
    const int fr = lane & 15, fq = lane >> 4;
    const int sr = tid >> 3, sc = (tid & 7) * 8;
    const int vgo = tid * 8;
    const unsigned vst = 9216u + (unsigned)((((tid >> 1) & 63) * KSTR) + (tid >> 7) * 16 + (tid & 1) * 8) * 2u;
    const int qbase = q0 + wave * 32 + fr;
    bf16x8 qf[2][2];
#pragma unroll
    for (int qg = 0; qg < 2; ++qg) { qf[qg][0] = *(const bf16x8*)(Qp + (size_t)(qbase + 16 * qg) * 64 + fq * 8); qf[qg][1] = *(const bf16x8*)(Qp + (size_t)(qbase + 16 * qg) * 64 + 32 + fq * 8); }
    f32x4 o[2][NB][4], l[2][NB]; float m[2][NB];
    const bf16x8 ones = (bf16x8){16256, 16256, 16256, 16256, 16256, 16256, 16256, 16256};
#pragma unroll
    for (int qg = 0; qg < 2; ++qg)
#pragma unroll
        for (int br = 0; br < NB; ++br) { m[qg][br] = (br == 0) ? m_init : -1e30f; { const float l0 = (br == 0 && sinkf) ? 1.f : 0.f; l[qg][br] = (f32x4){l0, l0, l0, l0}; }
#pragma unroll
            for (int dg = 0; dg < 4; ++dg) o[qg][br][dg] = (f32x4){0.f, 0.f, 0.f, 0.f}; }
    const unsigned stoff = (unsigned)(sr * KSTR + sc) * 2u;
#define TILEPOS(t) (((t) < nfirst) ? firstpos + 64 * (t) : secondpos + 64 * ((t) - nfirst))
    u32x4 kA, vA, kB, vB;
    kB = *(const u32x4*)(Kp + (size_t)(firstpos + sr) * 64 + sc); vB = *(const u32x4*)(Vp + (size_t)firstpos * 64 + vgo);
    { const int p1 = (1 < ntiles) ? TILEPOS(1) : firstpos; kA = *(const u32x4*)(Kp + (size_t)(p1 + sr) * 64 + sc); vA = *(const u32x4*)(Vp + (size_t)p1 * 64 + vgo); }
    *(LAS u32x4*)(lds + stoff) = kB; *(LAS u32x4*)(lds + vst) = vB;
    __syncthreads();
#pragma unroll 1
    for (int i2 = 0; i2 < ntiles; i2 += 2) {
        {   const int i = i2; const int buf = i & 1, curpos = TILEPOS(i); const bool more = (i + 1) < ntiles;
            { const int pos2 = (i + 2 < ntiles) ? TILEPOS(i + 2) : curpos;
              kB = *(const u32x4*)(Kp + (size_t)(pos2 + sr) * 64 + sc); vB = *(const u32x4*)(Vp + (size_t)pos2 * 64 + vgo); }
        const LAS unsigned char* Kt = lds + buf * ABUF_BYTES; const LAS unsigned char* Vt = Kt + 9216;
        float mf[2][NB]; f32x4 s[2][NB][4];
#pragma unroll
        for (int qg = 0; qg < 2; ++qg)
#pragma unroll
            for (int br = 0; br < NB; ++br) mf[qg][br] = (m[qg][br] < -1e29f) ? 0.f : m[qg][br];
        bf16x8 kfr[8];
#pragma unroll
        for (int g = 0; g < 4; ++g) { kfr[2 * g] = *(const LAS bf16x8*)(Kt + ((16 * g + fr) * KSTR + fq * 8) * 2); kfr[2 * g + 1] = *(const LAS bf16x8*)(Kt + ((16 * g + fr) * KSTR + 32 + fq * 8) * 2); }
        __builtin_amdgcn_sched_barrier(0);
#pragma unroll
        for (int g = 0; g < 4; ++g) {
            const bf16x8 k0 = kfr[2 * g], k1 = kfr[2 * g + 1];
#pragma unroll
            for (int qg = 0; qg < 2; ++qg) {
                const float c0 = -mf[qg][0];
                if (DIFF) { const float c1 = -mf[qg][NB - 1];
                    s[qg][0][g] = MFMA16(k0, qf[qg][0], ((f32x4){c0, c0, c0, c0})); s[qg][NB - 1][g] = MFMA16(k1, qf[qg][1], ((f32x4){c1, c1, c1, c1})); }
                else { s[qg][0][g] = MFMA16(k0, qf[qg][0], ((f32x4){c0, c0, c0, c0})); s[qg][0][g] = MFMA16(k1, qf[qg][1], s[qg][0][g]); }
            }
        }
        if (!DIFF && maskmode != 0 && i >= nfirst) {
            if (maskmode == 1) {
#pragma unroll
                for (int qg = 0; qg < 2; ++qg)
#pragma unroll
                    for (int g = 0; g < 4; ++g)
#pragma unroll
                        for (int j = 0; j < 4; ++j) { const int d = curpos + 16 * g + 4 * fq + j - (qbase + 16 * qg); s[qg][0][g][j] = (d <= 128 && d >= -128) ? s[qg][0][g][j] : -1e30f; }
            } else {
                const int kr = curpos >> 6;
#pragma unroll
                for (int qg = 0; qg < 2; ++qg) {
                    const int qrow = qbase + 16 * qg, r = qrow >> 6, c = qrow & 63;
                    const int rs = min(max(r - 4, 0), 24), cs = min(max(c - 8, 0), 48);
                    const bool rowok = (kr >= rs) && (kr < rs + 8);
                    const volatile LAS float* bb = bias + ((kr - r + 7) * 31 - c + 15 + 4 * fq);
                    float bv[4][4];
#pragma unroll
                    for (int g = 0; g < 4; ++g)
#pragma unroll
                        for (int j = 0; j < 4; ++j) bv[g][j] = bb[16 * g + j];
                    const int lo = cs - 4 * fq, hi = cs + 16 - 4 * fq;
#pragma unroll
                    for (int g = 0; g < 4; ++g)
#pragma unroll
                        for (int j = 0; j < 4; ++j) { const bool ok = rowok && (16 * g + j >= lo) && (16 * g + j < hi);
                            s[qg][0][g][j] = ok ? s[qg][0][g][j] + bv[g][j] : -1e30f; }
                }
            }
        }
        bf16x8 p[2][NB][2];
#pragma unroll
        for (int qg = 0; qg < 2; ++qg)
#pragma unroll
            for (int br = 0; br < NB; ++br) {
                f32x4 (&t)[4] = s[qg][br];
                int im = max(max(max(__builtin_bit_cast(int, t[0][0]), __builtin_bit_cast(int, t[0][1])), max(__builtin_bit_cast(int, t[0][2]), __builtin_bit_cast(int, t[0][3]))),
                             max(max(__builtin_bit_cast(int, t[1][0]), __builtin_bit_cast(int, t[1][1])), max(__builtin_bit_cast(int, t[1][2]), __builtin_bit_cast(int, t[1][3]))));
                im = max(im, max(max(max(__builtin_bit_cast(int, t[2][0]), __builtin_bit_cast(int, t[2][1])), max(__builtin_bit_cast(int, t[2][2]), __builtin_bit_cast(int, t[2][3]))),
                                 max(max(__builtin_bit_cast(int, t[3][0]), __builtin_bit_cast(int, t[3][1])), max(__builtin_bit_cast(int, t[3][2]), __builtin_bit_cast(int, t[3][3])))));
                if (__any(im > 0x41000000   || m[qg][br] < -1e29f)) {
                    float mx = fmaxf(fmaxf(fmaxf(t[0][0], t[0][1]), fmaxf(t[0][2], t[0][3])), fmaxf(fmaxf(t[1][0], t[1][1]), fmaxf(t[1][2], t[1][3])));
                    mx = fmaxf(mx, fmaxf(fmaxf(fmaxf(t[2][0], t[2][1]), fmaxf(t[2][2], t[2][3])), fmaxf(fmaxf(t[3][0], t[3][1]), fmaxf(t[3][2], t[3][3]))));
                    mx = fmaxf(mx, __shfl_xor(mx, 16)); mx = fmaxf(mx, __shfl_xor(mx, 32));
                    const float mabs = mx + mf[qg][br];
                    const float mn = fmaxf(m[qg][br], mabs), alpha = __builtin_amdgcn_exp2f(m[qg][br] - mn), shift = mn - mf[qg][br];
                    m[qg][br] = mn; l[qg][br] = l[qg][br] * alpha;
#pragma unroll
                    for (int g = 0; g < 4; ++g) t[g] = t[g] - shift;
#pragma unroll
                    for (int dg = 0; dg < 4; ++dg) o[qg][br][dg] = o[qg][br][dg] * alpha;
                }
#pragma unroll
                for (int g = 0; g < 4; ++g)
#pragma unroll
                    for (int j = 0; j < 4; ++j) t[g][j] = __builtin_amdgcn_exp2f(t[g][j]);
                u32x4 p0u, p1u;
                p0u.x = pk2v(t[0][0], t[0][1]); p0u.y = pk2v(t[0][2], t[0][3]); p0u.z = pk2v(t[1][0], t[1][1]); p0u.w = pk2v(t[1][2], t[1][3]);
                p1u.x = pk2v(t[2][0], t[2][1]); p1u.y = pk2v(t[2][2], t[2][3]); p1u.z = pk2v(t[3][0], t[3][1]); p1u.w = pk2v(t[3][2], t[3][3]);
                p[qg][br][0] = __builtin_bit_cast(bf16x8, p0u); p[qg][br][1] = __builtin_bit_cast(bf16x8, p1u);
                l[qg][br] = MFMA16(ones, p[qg][br][0], l[qg][br]); l[qg][br] = MFMA16(ones, p[qg][br][1], l[qg][br]);
            }
        u32x2 vfr[4][4];
#pragma unroll
        for (int dg = 0; dg < 4; ++dg) { const LAS unsigned char* vrow = Vt + ((16 * dg + fr) * KSTR + 4 * fq) * 2;
            vfr[dg][0] = *(const LAS u32x2*)(vrow); vfr[dg][1] = *(const LAS u32x2*)(vrow + 32); vfr[dg][2] = *(const LAS u32x2*)(vrow + 64); vfr[dg][3] = *(const LAS u32x2*)(vrow + 96); }
        __builtin_amdgcn_sched_barrier(0);
#pragma unroll
        for (int dg = 0; dg < 4; ++dg) {
            const u32x2 a = vfr[dg][0], b = vfr[dg][1], cc = vfr[dg][2], d = vfr[dg][3];
            u32x4 v0; v0.x = a.x; v0.y = a.y; v0.z = b.x; v0.w = b.y;
            u32x4 v1; v1.x = cc.x; v1.y = cc.y; v1.z = d.x; v1.w = d.y;
            const bf16x8 va0 = __builtin_bit_cast(bf16x8, v0), va1 = __builtin_bit_cast(bf16x8, v1);
#pragma unroll
            for (int qg = 0; qg < 2; ++qg)
#pragma unroll
                for (int br = 0; br < NB; ++br) { o[qg][br][dg] = MFMA16(va0, p[qg][br][0], o[qg][br][dg]); o[qg][br][dg] = MFMA16(va1, p[qg][br][1], o[qg][br][dg]); }
        }
        if (more) { *(LAS u32x4*)(lds + (buf ^ 1) * ABUF_BYTES + stoff) = kA; *(LAS u32x4*)(lds + (buf ^ 1) * ABUF_BYTES + vst) = vA; }
        __syncthreads();
        }
        if (i2 + 1 >= ntiles) break;
        {   const int i = i2 + 1; const int buf = i & 1, curpos = TILEPOS(i); const bool more = (i + 1) < ntiles;
            { const int pos2 = (i + 2 < ntiles) ? TILEPOS(i + 2) : curpos;
              kA = *(const u32x4*)(Kp + (size_t)(pos2 + sr) * 64 + sc); vA = *(const u32x4*)(Vp + (size_t)pos2 * 64 + vgo); }
        const LAS unsigned char* Kt = lds + buf * ABUF_BYTES; const LAS unsigned char* Vt = Kt + 9216;
        float mf[2][NB]; f32x4 s[2][NB][4];
#pragma unroll
        for (int qg = 0; qg < 2; ++qg)
#pragma unroll
            for (int br = 0; br < NB; ++br) mf[qg][br] = (m[qg][br] < -1e29f) ? 0.f : m[qg][br];
        bf16x8 kfr[8];
#pragma unroll
        for (int g = 0; g < 4; ++g) { kfr[2 * g] = *(const LAS bf16x8*)(Kt + ((16 * g + fr) * KSTR + fq * 8) * 2); kfr[2 * g + 1] = *(const LAS bf16x8*)(Kt + ((16 * g + fr) * KSTR + 32 + fq * 8) * 2); }
        __builtin_amdgcn_sched_barrier(0);
#pragma unroll
        for (int g = 0; g < 4; ++g) {
            const bf16x8 k0 = kfr[2 * g], k1 = kfr[2 * g + 1];
#pragma unroll
            for (int qg = 0; qg < 2; ++qg) {
                const float c0 = -mf[qg][0];
                if (DIFF) { const float c1 = -mf[qg][NB - 1];
                    s[qg][0][g] = MFMA16(k0, qf[qg][0], ((f32x4){c0, c0, c0, c0})); s[qg][NB - 1][g] = MFMA16(k1, qf[qg][1], ((f32x4){c1, c1, c1, c1})); }
                else { s[qg][0][g] = MFMA16(k0, qf[qg][0], ((f32x4){c0, c0, c0, c0})); s[qg][0][g] = MFMA16(k1, qf[qg][1], s[qg][0][g]); }
            }
        }
        if (!DIFF && maskmode != 0 && i >= nfirst) {
            if (maskmode == 1) {
#pragma unroll
                for (int qg = 0; qg < 2; ++qg)
#pragma unroll
                    for (int g = 0; g < 4; ++g)
#pragma unroll
                        for (int j = 0; j < 4; ++j) { const int d = curpos + 16 * g + 4 * fq + j - (qbase + 16 * qg); s[qg][0][g][j] = (d <= 128 && d >= -128) ? s[qg][0][g][j] : -1e30f; }
            } else {
                const int kr = curpos >> 6;
#pragma unroll
                for (int qg = 0; qg < 2; ++qg) {
                    const int qrow = qbase + 16 * qg, r = qrow >> 6, c = qrow & 63;
                    const int rs = min(max(r - 4, 0), 24), cs = min(max(c - 8, 0), 48);
                    const bool rowok = (kr >= rs) && (kr < rs + 8);
                    const volatile LAS float* bb = bias + ((kr - r + 7) * 31 - c + 15 + 4 * fq);
                    float bv[4][4];
#pragma unroll
                    for (int g = 0; g < 4; ++g)
#pragma unroll
                        for (int j = 0; j < 4; ++j) bv[g][j] = bb[16 * g + j];
                    const int lo = cs - 4 * fq, hi = cs + 16 - 4 * fq;
#pragma unroll
                    for (int g = 0; g < 4; ++g)
#pragma unroll
                        for (int j = 0; j < 4; ++j) { const bool ok = rowok && (16 * g + j >= lo) && (16 * g + j < hi);
                            s[qg][0][g][j] = ok ? s[qg][0][g][j] + bv[g][j] : -1e30f; }
                }
            }
        }
        bf16x8 p[2][NB][2];
#pragma unroll
        for (int qg = 0; qg < 2; ++qg)
#pragma unroll
            for (int br = 0; br < NB; ++br) {
                f32x4 (&t)[4] = s[qg][br];
                int im = max(max(max(__builtin_bit_cast(int, t[0][0]), __builtin_bit_cast(int, t[0][1])), max(__builtin_bit_cast(int, t[0][2]), __builtin_bit_cast(int, t[0][3]))),
                             max(max(__builtin_bit_cast(int, t[1][0]), __builtin_bit_cast(int, t[1][1])), max(__builtin_bit_cast(int, t[1][2]), __builtin_bit_cast(int, t[1][3]))));
                im = max(im, max(max(max(__builtin_bit_cast(int, t[2][0]), __builtin_bit_cast(int, t[2][1])), max(__builtin_bit_cast(int, t[2][2]), __builtin_bit_cast(int, t[2][3]))),
                                 max(max(__builtin_bit_cast(int, t[3][0]), __builtin_bit_cast(int, t[3][1])), max(__builtin_bit_cast(int, t[3][2]), __builtin_bit_cast(int, t[3][3])))));
                if (__any(im > 0x41000000   || m[qg][br] < -1e29f)) {
                    float mx = fmaxf(fmaxf(fmaxf(t[0][0], t[0][1]), fmaxf(t[0][2], t[0][3])), fmaxf(fmaxf(t[1][0], t[1][1]), fmaxf(t[1][2], t[1][3])));
                    mx = fmaxf(mx, fmaxf(fmaxf(fmaxf(t[2][0], t[2][1]), fmaxf(t[2][2], t[2][3])), fmaxf(fmaxf(t[3][0], t[3][1]), fmaxf(t[3][2], t[3][3]))));
                    mx = fmaxf(mx, __shfl_xor(mx, 16)); mx = fmaxf(mx, __shfl_xor(mx, 32));
                    const float mabs = mx + mf[qg][br];
                    const float mn = fmaxf(m[qg][br], mabs), alpha = __builtin_amdgcn_exp2f(m[qg][br] - mn), shift = mn - mf[qg][br];
                    m[qg][br] = mn; l[qg][br] = l[qg][br] * alpha;
#pragma unroll
                    for (int g = 0; g < 4; ++g) t[g] = t[g] - shift;
#pragma unroll
                    for (int dg = 0; dg < 4; ++dg) o[qg][br][dg] = o[qg][br][dg] * alpha;
                }
#pragma unroll
                for (int g = 0; g < 4; ++g)
#pragma unroll
                    for (int j = 0; j < 4; ++j) t[g][j] = __builtin_amdgcn_exp2f(t[g][j]);
                u32x4 p0u, p1u;
                p0u.x = pk2v(t[0][0], t[0][1]); p0u.y = pk2v(t[0][2], t[0][3]); p0u.z = pk2v(t[1][0], t[1][1]); p0u.w = pk2v(t[1][2], t[1][3]);
                p1u.x = pk2v(t[2][0], t[2][1]); p1u.y = pk2v(t[2][2], t[2][3]); p1u.z = pk2v(t[3][0], t[3][1]); p1u.w = pk2v(t[3][2], t[3][3]);
                p[qg][br][0] = __builtin_bit_cast(bf16x8, p0u); p[qg][br][1] = __builtin_bit_cast(bf16x8, p1u);
                l[qg][br] = MFMA16(ones, p[qg][br][0], l[qg][br]); l[qg][br] = MFMA16(ones, p[qg][br][1], l[qg][br]);
            }
        u32x2 vfr[4][4];
#pragma unroll
        for (int dg = 0; dg < 4; ++dg) { const LAS unsigned char* vrow = Vt + ((16 * dg + fr) * KSTR + 4 * fq) * 2;
            vfr[dg][0] = *(const LAS u32x2*)(vrow); vfr[dg][1] = *(const LAS u32x2*)(vrow + 32); vfr[dg][2] = *(const LAS u32x2*)(vrow + 64); vfr[dg][3] = *(const LAS u32x2*)(vrow + 96); }
        __builtin_amdgcn_sched_barrier(0);
#pragma unroll
        for (int dg = 0; dg < 4; ++dg) {
            const u32x2 a = vfr[dg][0], b = vfr[dg][1], cc = vfr[dg][2], d = vfr[dg][3];
            u32x4 v0; v0.x = a.x; v0.y = a.y; v0.z = b.x; v0.w = b.y;
            u32x4 v1; v1.x = cc.x; v1.y = cc.y; v1.z = d.x; v1.w = d.y;
            const bf16x8 va0 = __builtin_bit_cast(bf16x8, v0), va1 = __builtin_bit_cast(bf16x8, v1);
#pragma unroll
            for (int qg = 0; qg < 2; ++qg)
#pragma unroll
                for (int br = 0; br < NB; ++br) { o[qg][br][dg] = MFMA16(va0, p[qg][br][0], o[qg][br][dg]); o[qg][br][dg] = MFMA16(va1, p[qg][br][1], o[qg][br][dg]); }
        }
        if (more) { *(LAS u32x4*)(lds + (buf ^ 1) * ABUF_BYTES + stoff) = kB; *(LAS u32x4*)(lds + (buf ^ 1) * ABUF_BYTES + vst) = vB; }
        __syncthreads();
        }
    }
#undef TILEPOS
#pragma unroll
    for (int qg = 0; qg < 2; ++qg) {
        const float inv1 = 1.0f / l[qg][0][0];
        bf16_t* yr = Yp + (size_t)(wave * 32 + qg * 16 + fr) * 1024 + 4 * fq;
        if (DIFF) {
            const float inv2 = lam / l[qg][NB - 1][0];
            f32x4 y[4]; float ss = 0.f;
#pragma unroll
            for (int dg = 0; dg < 4; ++dg) { y[dg] = o[qg][0][dg] * inv1 - o[qg][NB - 1][dg] * inv2; ss += (y[dg][0] * y[dg][0] + y[dg][1] * y[dg][1]) + (y[dg][2] * y[dg][2] + y[dg][3] * y[dg][3]); }
            ss += __shfl_xor(ss, 16); ss += __shfl_xor(ss, 32);
            const float rr = oscale / sqrtf(ss * (1.0f / 64.0f) + 1e-6f);
#pragma unroll
            for (int dg = 0; dg < 4; ++dg) { const f32x4 gv = *(const f32x4*)(subg + 16 * dg + 4 * fq); const f32x4 yy = y[dg] * rr * gv;
                *(unsigned long long*)(yr + 16 * dg) = (unsigned long long)pk2(yy[0], yy[1]) | ((unsigned long long)pk2(yy[2], yy[3]) << 32); }
        } else {
#pragma unroll
            for (int dg = 0; dg < 4; ++dg) { const f32x4 yy = o[qg][0][dg] * inv1;
                *(unsigned long long*)(yr + 16 * dg) = (unsigned long long)pk2(yy[0], yy[1]) | ((unsigned long long)pk2(yy[2], yy[3]) << 32); }
        }
    }
}

__device__ __forceinline__ void attn_phase(LAS unsigned char* lds, unsigned* counter, bool with_ctx, const bf16_t* Qb, const bf16_t* Kb, const bf16_t* Vtb, bf16_t* Y,
                                           const float* sink, const float* relb, const float* subg, float lam, float oscale, int tid, int lane, int wave) {
    const int nunits = with_ctx ? 1152 : 1024;
    LAS float* bias = (LAS float*)(lds + ATT_BIAS_OFF);
    LAS int* cur = (LAS int*)(lds + ATT_CUR_OFF);
    for (;;) {
        if (tid == 0) *cur = (int)atomicAdd(counter, 1u);
        __syncthreads();
        const int u = *cur;
        __syncthreads();
        if (u >= nunits) break;
        int mo, b, h, q0;
        if (u < 1024) { mo = u >> 8; const int i = u & 255; b = i >> 5; h = (i >> 3) & 3; q0 = (i & 7) * 256; }
        else { const int v = u - 1024; mo = v >> 5; const int i = v & 31; b = i >> 2; h = i & 3; q0 = 2048; }
        const int mixer = mo == 0 ? 3 : (mo == 1 ? 1 : (mo == 2 ? 2 : 0));
        const int kvh = (mixer < 2) ? (h >> 1) : h;
        const int kvbase = mixer == 0 ? 0 : (mixer == 1 ? 2 : (mixer == 2 ? 4 : 8));
        const bf16_t* Qp = Qb + (size_t)((mixer * 8 + b) * 4 + h) * POS * 64;
        const bf16_t* Kp = Kb + (size_t)((kvbase + kvh) * 8 + b) * POS * 64;
        const bf16_t* Vp = Vtb + (size_t)((kvbase + kvh) * 8 + b) * POS * 64;
        const bool isctx = q0 >= 2048;
        const int yrow0 = isctx ? ML + b * 256 : b * 2048 + q0;
        bf16_t* Yp = Y + (size_t)yrow0 * 1024 + mixer * 256 + h * 64;
        int ntiles, nfirst, firstpos, secondpos = 0, maskmode = 0;
        if (isctx) { ntiles = 4; nfirst = 4; firstpos = 2048; }
        else if (mixer == 1 || mixer == 3) { ntiles = 36; nfirst = 36; firstpos = 0; }
        else if (mixer == 0) { const int lo = max(0, q0 - 128), hi = min(2048, q0 + 384); nfirst = 4; firstpos = 2048; secondpos = lo; ntiles = 4 + (hi - lo) / 64; maskmode = 1; }
        else { const int r0 = q0 >> 6; const int rs0 = min(max(r0 - 4, 0), 24), rs3 = min(max(r0 - 1, 0), 24); nfirst = 4; firstpos = 2048; secondpos = rs0 * 64; ntiles = 4 + (rs3 + 8 - rs0); maskmode = 2;
            for (int i = tid; i < 465; i += NT) bias[i] = relb[h * 465 + i] * LOG2E; }
        float m_init = -1e30f; bool sinkf = false;
        if (mixer == 0) { m_init = sink[h] * LOG2E; sinkf = true; }
        if (mixer == 3) attn_unit<true>(lds, Qp, Kp, Vp, Yp, q0, ntiles, nfirst, firstpos, secondpos, 0, -1e30f, false, bias, lam, subg, oscale, wave);
        else attn_unit<false>(lds, Qp, Kp, Vp, Yp, q0, ntiles, nfirst, firstpos, secondpos, maskmode, m_init, sinkf, bias, 0.f, subg, 1.f, wave);
    }
}

struct Args { const float* in[24]; float* out; unsigned char* ws; };
#define CAS __attribute__((address_space(4)))
__device__ __forceinline__ const CAS char* kargs() { const CAS char* p = (const CAS char*)__builtin_amdgcn_kernarg_segment_ptr(); asm volatile("" : "+s"(p)); return p; }
__device__ __forceinline__ const float* ldin(int i) { return *(const float* const CAS*)(kargs() + 8 * i); }
__device__ __forceinline__ float* ldout() { return *(float* const CAS*)(kargs() + 192); }
__device__ __forceinline__ unsigned char* ldws() { return *(unsigned char* const CAS*)(kargs() + 200); }
__global__ void __launch_bounds__(NT, 2) fwd_kernel(Args a) {
    extern __shared__ __attribute__((aligned(16))) unsigned char lds_raw[];
    LAS unsigned char* lds = (LAS unsigned char*)lds_raw;
    cg::grid_group grid = cg::this_grid();
#define TID (tid_now())
#define LANE (TID & 63)
#define WAVE (__builtin_amdgcn_readfirstlane(TID >> 6))
#define GRD (grd_now())
#define BID (bid_now())
#define GW (BID * 8 + WAVE)
#define NGW (GRD * 8)
#define WSF(off) ((float*)(ldws() + (off)))
#define WSB(off) ((bf16_t*)(ldws() + (off)))

    if (grd_now() == 0x7fffffff) grid.sync();
    if (tid_now() < 16) ((LAS unsigned*)(lds + MISC_OFF))[tid_now()] = 0u;
    __syncthreads();
    (void)xcd_barrier_post((unsigned*)(ldws() + WS_BAR), (volatile LAS unsigned*)(lds + MISC_OFF));
    if (BID == GRD - 1) p0_misc(WSF(WS_ROPE), WSF(WS_SCAL), ldin(15), ldin(16), ldin(17), ldin(18), TID);
#pragma unroll 1
    for (int rep = 0; rep < REP_LIGHT; ++rep)
    p0_mod(lds, ldin(1), ldin(3), ldin(4), ldin(5), WSF(WS_MOD), BID, GRD, TID);
    GSYNC();

#define FUSE (GRD == 256)
#define MODL(ll) (WSF(WS_MOD) + (size_t)(ll) * 9 * 9216)
#define CNT(inst) ((unsigned*)(ldws() + WS_CNT) + (inst) * 64 * 16)
#pragma unroll 1
    for (int it = 0; it < 4; ++it) {
        const int l = it >> 1, f = it & 1;
        const bool lat_only = (l == 1 && f == 1);
        if (f == 0) convert_layer(lds, l, ldin(6), ldin(7), ldin(8), ldin(9), ldin(10), ldin(20), ldin(21), ldin(22), ldws() + WS_W, GW, NGW, WAVE, LANE);
        if (it == 0) norm_mod_phase(ldin(0), ldin(2), nullptr, nullptr, nullptr, WSF(WS_XC), WSB(WS_H), MODL(0), 0, 0, MT, GW, NGW, LANE);
        else if (!FUSE) norm_mod_phase(ldout(), WSF(WS_XC), nullptr, nullptr, (it == 1 || it == 2) ? SPLIT_PART : nullptr, WSF(WS_XC), WSB(WS_H), MODL(l), f ? 6 : 0, 0, lat_only ? ML : MT, GW, NGW, LANE);
        else if (!lat_only) norm_mod_phase(ldout(), WSF(WS_XC), nullptr, nullptr, SPLIT_PART, WSF(WS_XC), WSB(WS_H), MODL(l), f ? 6 : 0, ML, MT, GW, NGW, LANE);
        if (!(FUSE && lat_only)) GSYNC();
        {
            const int M = lat_only ? ML : MT;
            pg8::Gemm g{WSB(WS_H), (const bf16_t*)(ldws() + WS_W + (f ? W_GU2 : W_GU1)), M, 2 * DFF, DM}; pg8::StaticOrder S; S.init(M, 2 * DFF, GRD, BID, DM);
            pg8::EpiSwiglu E{WSB(WS_G), DFF};
            pg8::gemm_phase<pg8::EpiSwiglu, pg8::StaticOrder, true, true>(lds, g, S, E);
        }
        GSYNC();
        {
            const int M = lat_only ? ML : MT;
            pg8::Gemm g{WSB(WS_G), (const bf16_t*)(ldws() + WS_W + (f ? W_D2 : W_D1)), M, DM, DFF}; pg8::SplitOrder S; S.init(M, DM, GRD, BID, DFF);
            const float* nsh = (f == 0) ? MODL(l) + 3 * 1024 : ((it == 1) ? MODL(1) : ldin(23));
            pg8::EpiRes E{ldout(), WSF(WS_XC), MODL(l) + (f ? 8 : 2) * 1024, 0.5f, DFF / 64, WSF(WS_Q), (it == 0) ? ldin(0) : (const float*)ldout(), (it == 0) ? ldin(2) : (const float*)WSF(WS_XC), FUSE ? 1 : 0, (it == 3) ? 1 : 0, WSB(WS_H), nsh, WSF(WS_SLOTS), CNT(it)};
            pg8::gemm_phase<pg8::EpiRes, pg8::SplitOrder, true, true>(lds, g, S, E);
        }
        if (it < 3) GSYNC();
        if (f == 0) {
            if (!FUSE) norm_mod_phase(ldout(), (it == 0 && SPLIT_PART) ? ldin(2) : (const float*)WSF(WS_XC), nullptr, nullptr, SPLIT_PART, WSF(WS_XC), WSB(WS_H), MODL(l), 3, 0, MT, GW, NGW, LANE);
            else norm_mod_phase(ldout(), (it == 0) ? ldin(2) : (const float*)WSF(WS_XC), nullptr, nullptr, SPLIT_PART, WSF(WS_XC), WSB(WS_H), MODL(l), 3, ML, MT, GW, NGW, LANE);
            GSYNC();
            {
                pg8::Gemm g{WSB(WS_H), (const bf16_t*)(ldws() + WS_W + W_IN), MT, INW, DM}; pg8::StaticOrder S; S.init(MT, INW, GRD, BID, DM);
                pg8::EpiQKV E{WSB(WS_Q), WSB(WS_K), WSB(WS_VT), WSF(WS_ROPE), ldin(12) + l * 64, ldin(13) + l * 64, lds + 131072};
#pragma unroll 1
                for (int rep = 0; rep < REP_GU; ++rep)
                pg8::gemm_phase<pg8::EpiQKV, pg8::StaticOrder, true, true>(lds, g, S, E);
            }
            GSYNC();
            {
                const float lam = __hip_atomic_load(WSF(WS_SCAL) + l, __ATOMIC_RELAXED, __HIP_MEMORY_SCOPE_AGENT); const float lam_init = 0.8f - 0.6f * expf(-0.3f * (float)l);
#pragma unroll 1
                for (int rep = 0; rep < REP_ATT; ++rep)
                attn_phase(lds, (unsigned*)(ldws() + WS_CTL) + 64 * l + 16 * rep, l == 0, WSB(WS_Q), WSB(WS_K), WSB(WS_VT), WSB(WS_H), ldin(11) + l * 4, ldin(14) + l * 4 * 465, ldin(19) + l * 64, lam, 1.0f - lam_init, TID, LANE, WAVE);
            }
            GSYNC();
            {
                const int M = (l == 1) ? ML : MT;
                pg8::Gemm g{WSB(WS_H), (const bf16_t*)(ldws() + WS_W + W_OUT), M, DM, DM}; pg8::SplitOrder S; S.init(M, DM, GRD, BID, DM);
                pg8::EpiRes E{ldout(), WSF(WS_XC), MODL(l) + 5 * 1024, 1.0f, DM / 64, WSF(WS_Q), (const float*)ldout(), (const float*)WSF(WS_XC), FUSE ? 1 : 0, 0, WSB(WS_H), MODL(l) + 6 * 1024, WSF(WS_SLOTS), CNT(4 + l)};
                pg8::gemm_phase<pg8::EpiRes, pg8::SplitOrder, true, true>(lds, g, S, E);
            }
            GSYNC();
        }
    }
    if (!FUSE) { GSYNC(); final_norm_phase(ldout(), ldin(23), GW, NGW, LANE); }

}

extern "C" void kernel_launch(void* const* d_in, const int* in_sizes, int n_in, void* d_out, int out_size, void* d_ws, size_t ws_size, hipStream_t stream) {
    static int grid = 0;
    if (grid == 0) {
        if (n_in != 24 || out_size != ML * DM || ws_size < WS_END) { fprintf(stderr, "kernel_launch: unexpected shapes (n_in %d out %d ws %zu)\n", n_in, out_size, ws_size); grid = -1; return; }
        int dev = 0, cus = 0, per_cu = 0;
        (void)hipGetDevice(&dev);
        (void)hipDeviceGetAttribute(&cus, hipDeviceAttributeMultiprocessorCount, dev);
        (void)hipFuncSetAttribute((const void*)fwd_kernel, hipFuncAttributeMaxDynamicSharedMemorySize, LDS_BYTES);
        if (hipOccupancyMaxActiveBlocksPerMultiprocessor(&per_cu, (const void*)fwd_kernel, NT, LDS_BYTES) != hipSuccess || per_cu < 1) per_cu = 1;
        (void)hipGetLastError();
        grid = cus * 1;
    }
    if (grid < 0) return;
    (void)hipMemsetAsync((char*)d_ws + WS_CTL, 0, CTL_ZERO_BYTES, stream);
    Args a{};
    for (int i = 0; i < 24; ++i) a.in[i] = (const float*)d_in[i];
    a.out = (float*)d_out; a.ws = (unsigned char*)d_ws;
    void* args[] = {&a};
    hipError_t e = hipLaunchCooperativeKernel((const void*)fwd_kernel, dim3(grid), dim3(NT), args, LDS_BYTES, stream);
    if (e != hipSuccess) fprintf(stderr, "cooperative launch failed: %s (grid %d)\n", hipGetErrorString(e), grid);
}
```
